# Optimizing an MI355X kernel written in HIP

```python
import jax, jax.numpy as jnp
from jax import lax
import numpy as np

D_MODEL = 2048
BATCH = 2
SEQ = 8192
DEPTH = 4

GRID_W = 64
CTX_LEN = 256
HEAD_DIM = 128
MIX_WIDTH = D_MODEL
H_A = 4
KV_A = 2
H_B = 6
H_C = 6
KV_C = 2
D_FF = 4 * D_MODEL
Q_BLOCK = 128
NA_ROWS = 8
NA_COLS = 16
WINDOW = 128
ROPE_THETA = 10000.0
EPS = 1e-6
N_MOD = 6
ATTN_SCALE = HEAD_DIM ** -0.5
NEG_INF = -1e30

_SIZES = (H_A * HEAD_DIM, KV_A * HEAD_DIM, KV_A * HEAD_DIM,
          H_B * HEAD_DIM, H_B * HEAD_DIM, H_B * HEAD_DIM,
          H_C * HEAD_DIM, KV_C * HEAD_DIM, KV_C * HEAD_DIM)
D_IN = sum(_SIZES)
SPLIT_IDX = tuple(int(v) for v in np.cumsum(_SIZES)[:-1])

kernel_name = "hybrid_parallel_heads_dit_trunk"


def _rmsnorm(x, g):
    xf = x.astype(jnp.float32)
    y = xf * lax.rsqrt(jnp.mean(xf * xf, axis=-1, keepdims=True) + EPS)
    return (y * g.astype(jnp.float32)).astype(x.dtype)


def _modulate(h, shift, scale):
    return h * (1 + scale) + shift


def _heads(t):
    return t.reshape(t.shape[:-1] + (t.shape[-1] // HEAD_DIM, HEAD_DIM))


def _axial_rope_tables(length, dtype):
    t = jnp.arange(length)
    row = (t // GRID_W).astype(jnp.float32)
    col = (t % GRID_W).astype(jnp.float32)
    nf = HEAD_DIM // 4
    inv = ROPE_THETA ** (-jnp.arange(nf, dtype=jnp.float32) / nf)
    ar = row[:, None] * inv
    ac = col[:, None] * inv
    ang = jnp.concatenate([ar, ar, ac, ac], axis=-1)
    return jnp.cos(ang)[:, None, :].astype(dtype), jnp.sin(ang)[:, None, :].astype(dtype)


def _rope(x, cos, sin):
    xs = x.reshape(x.shape[:-1] + (2, 2, HEAD_DIM // 4))
    rot = jnp.concatenate([-xs[..., 1:, :], xs[..., :1, :]], axis=-2).reshape(x.shape)
    return x * cos + rot * sin


def _qkv_heads(h, w, qn, kn):
    pa_q, pa_k, pa_v, pb_q, pb_k, pb_v, pc_q, pc_k, pc_v = jnp.split(h @ w, SPLIT_IDX, axis=-1)
    qa = _rmsnorm(_heads(pa_q), qn[0]); ka = _rmsnorm(_heads(pa_k), kn[0]); va = _heads(pa_v)
    qb = _rmsnorm(_heads(pb_q), qn[1]); kb = _rmsnorm(_heads(pb_k), kn[1]); vb = _heads(pb_v)
    qc = _rmsnorm(_heads(pc_q), qn[2]); kc = _rmsnorm(_heads(pc_k), kn[2]); vc = _heads(pc_v)
    return (qa, ka, va, qb, kb, vb, qc, kc, vc)


def _dense_ctx_attn(q, k, v, sink=None):
    b, n, hq, d = q.shape
    hkv = k.shape[2]
    g = hq // hkv
    qg = q.reshape(b, n, hkv, g, d)
    s = jnp.einsum('bqhgd,bkhd->bhgqk', qg, k).astype(jnp.float32) * ATTN_SCALE
    if sink is None:
        p = jax.nn.softmax(s, axis=-1)
    else:
        sk = jnp.broadcast_to(sink.reshape(hkv, g).astype(jnp.float32)[None, :, :, None, None],
                              s.shape[:-1] + (1,))
        p = jax.nn.softmax(jnp.concatenate([s, sk], axis=-1), axis=-1)[..., :-1]
    o = jnp.einsum('bhgqk,bkhd->bqhgd', p.astype(v.dtype), v)
    return o.reshape(b, n, hq * d)


def _global_attn(q, k, v, k_ctx, v_ctx):
    b, L, hq, d = q.shape
    hkv = k.shape[2]
    g = hq // hkv
    nb = L // Q_BLOCK
    k_all = jnp.concatenate([k_ctx, k], axis=1)
    v_all = jnp.concatenate([v_ctx, v], axis=1)
    qb = q.reshape(b, nb, Q_BLOCK, hkv, g, d).transpose(1, 0, 2, 3, 4, 5)

    def block(qi):
        s = jnp.einsum('bqhgd,bkhd->bhgqk', qi, k_all).astype(jnp.float32) * ATTN_SCALE
        p = jax.nn.softmax(s, axis=-1).astype(v_all.dtype)
        return jnp.einsum('bhgqk,bkhd->bqhgd', p, v_all)

    o = lax.map(block, qb)
    return o.transpose(1, 0, 2, 3, 4, 5).reshape(b, L, hq * d)


def _neighbourhood_attn(q, k, v, k_ctx, v_ctx, rpb):
    b, L, h, d = q.shape
    rows = L // GRID_W
    kh = min(NA_ROWS, rows)
    kw = NA_COLS
    qg = q.reshape(b, rows, GRID_W, h, d)
    kg = k.reshape(b, rows, GRID_W, h, d)
    vg = v.reshape(b, rows, GRID_W, h, d)
    cols = np.arange(GRID_W)
    cs = np.clip(cols - kw // 2, 0, GRID_W - kw)
    col_idx = cs[:, None] + np.arange(kw)[None, :]
    col_rel = col_idx - cols[:, None] + (kw - 1)
    rpb_cols = rpb[:, :, col_rel]

    def row(r):
        rs = jnp.clip(r - kh // 2, 0, rows - kh)
        k_win = lax.dynamic_slice_in_dim(kg, rs, kh, axis=1)[:, :, col_idx]
        v_win = lax.dynamic_slice_in_dim(vg, rs, kh, axis=1)[:, :, col_idx]
        q_row = lax.dynamic_index_in_dim(qg, r, axis=1, keepdims=False)
        row_rel = rs + jnp.arange(kh) - r + (NA_ROWS - 1)
        bias = jnp.take(rpb_cols, row_rel, axis=1).transpose(0, 2, 1, 3)
        s_loc = (jnp.einsum('bqhd,biqjhd->bhqij', q_row, k_win).astype(jnp.float32) * ATTN_SCALE
                 + bias[None].astype(jnp.float32))
        s_ctx = jnp.einsum('bqhd,bkhd->bhqk', q_row, k_ctx).astype(jnp.float32) * ATTN_SCALE
        s = jnp.concatenate([s_loc.reshape(b, h, GRID_W, kh * kw), s_ctx], axis=-1)
        p = jax.nn.softmax(s, axis=-1).astype(v.dtype)
        p_loc = p[..., :kh * kw].reshape(b, h, GRID_W, kh, kw)
        p_ctx = p[..., kh * kw:]
        return (jnp.einsum('bhqij,biqjhd->bqhd', p_loc, v_win)
                + jnp.einsum('bhqk,bkhd->bqhd', p_ctx, v_ctx))

    o = lax.map(row, jnp.arange(rows))
    return o.transpose(1, 0, 2, 3, 4).reshape(b, L, h * d)


def _window_attn(q, k, v, k_ctx, v_ctx, sink):
    b, L, hq, d = q.shape
    hkv = k.shape[2]
    g = hq // hkv
    nb = L // WINDOW
    qb = q.reshape(b, nb, WINDOW, hkv, g, d)
    pad = ((0, 0), (WINDOW, WINDOW), (0, 0), (0, 0))
    kp = jnp.pad(k, pad).reshape(b, nb + 2, WINDOW, hkv, d)
    vp = jnp.pad(v, pad).reshape(b, nb + 2, WINDOW, hkv, d)
    k_band = jnp.concatenate([kp[:, :-2], kp[:, 1:-1], kp[:, 2:]], axis=2)
    v_band = jnp.concatenate([vp[:, :-2], vp[:, 1:-1], vp[:, 2:]], axis=2)
    a = np.arange(WINDOW)[:, None]
    kk = np.arange(3 * WINDOW)[None, :]
    in_band = np.abs(kk - WINDOW - a) <= WINDOW
    kpos = (np.arange(nb)[:, None] - 1) * WINDOW + kk
    in_seq = (kpos >= 0) & (kpos < L)
    mask = in_band[None] & in_seq[:, None, :]
    s_band = jnp.einsum('bnqhgd,bnkhd->bnhgqk', qb, k_band).astype(jnp.float32) * ATTN_SCALE
    s_band = jnp.where(mask[None, :, None, None], s_band, NEG_INF)
    s_ctx = jnp.einsum('bnqhgd,bkhd->bnhgqk', qb, k_ctx).astype(jnp.float32) * ATTN_SCALE
    sk = jnp.broadcast_to(sink.reshape(hkv, g).astype(jnp.float32)[None, None, :, :, None, None],
                          s_band.shape[:-1] + (1,))
    p = jax.nn.softmax(jnp.concatenate([s_band, s_ctx, sk], axis=-1), axis=-1)
    nk = 3 * WINDOW
    nc = k_ctx.shape[1]
    p_band = p[..., :nk].astype(v.dtype)
    p_ctx = p[..., nk:nk + nc].astype(v.dtype)
    o = (jnp.einsum('bnhgqk,bnkhd->bnqhgd', p_band, v_band)
         + jnp.einsum('bnhgqk,bkhd->bnqhgd', p_ctx, v_ctx))
    return o.reshape(b, L, hq * d)


def _sq_relu_mlp(h, w_up, w_down):
    return jnp.square(jax.nn.relu(h @ w_up)) @ w_down


def setup_inputs(seed: int = 0) -> dict:
    key = jax.random.key(seed)
    ks = jax.random.split(key, 16)
    n = jax.random.normal
    f32 = jnp.float32
    return {
        "x": n(ks[0], (BATCH, SEQ, D_MODEL), f32),
        "c": n(ks[1], (BATCH, D_MODEL), f32),
        "ctx": n(ks[2], (BATCH, CTX_LEN, D_MODEL), f32),
        "c_ctx": n(ks[3], (D_MODEL,), f32),
        "w_mod": n(ks[4], (DEPTH, D_MODEL, N_MOD * D_MODEL), f32) * (0.5 * D_MODEL ** -0.5),
        "b_mod": n(ks[5], (DEPTH, N_MOD * D_MODEL), f32) * 0.02,
        "norm_attn": 1.0 + 0.02 * n(ks[6], (DEPTH, D_MODEL), f32),
        "norm_mlp": 1.0 + 0.02 * n(ks[7], (DEPTH, D_MODEL), f32),
        "w_in": n(ks[8], (DEPTH, D_MODEL, D_IN), f32) * D_MODEL ** -0.5,
        "q_norm": 1.0 + 0.02 * n(ks[9], (DEPTH, 3, HEAD_DIM), f32),
        "k_norm": 1.0 + 0.02 * n(ks[10], (DEPTH, 3, HEAD_DIM), f32),
        "rel_pos_bias": 0.1 * n(ks[11], (DEPTH, H_B, 2 * NA_ROWS - 1, 2 * NA_COLS - 1), f32),
        "sink_logits": 0.5 * n(ks[12], (DEPTH, H_C), f32),
        "w_out": n(ks[13], (DEPTH, MIX_WIDTH, D_MODEL), f32) * MIX_WIDTH ** -0.5,
        "w_up": n(ks[14], (DEPTH, D_MODEL, D_FF), f32) * D_MODEL ** -0.5,
        "w_down": n(ks[15], (DEPTH, D_FF, D_MODEL), f32) * D_FF ** -0.5,
    }


def reference(x, c, ctx, c_ctx, w_mod, b_mod, norm_attn, norm_mlp, w_in, q_norm, k_norm,
              rel_pos_bias, sink_logits, w_out, w_up, w_down):
    L = x.shape[1]
    cos, sin = _axial_rope_tables(L, x.dtype)
    cond = jax.nn.silu(c)
    cond_ctx = jax.nn.silu(c_ctx)
    cs_ = ctx
    for l in range(DEPTH):
        last = l == DEPTH - 1
        mod = (cond @ w_mod[l] + b_mod[l])[:, None, :]
        sh1, sc1, g1, sh2, sc2, g2 = jnp.split(mod, N_MOD, axis=-1)
        modc = cond_ctx @ w_mod[l] + b_mod[l]
        sh1c, sc1c, g1c, sh2c, sc2c, g2c = jnp.split(modc, N_MOD, axis=-1)

        h = _modulate(_rmsnorm(x, norm_attn[l]), sh1, sc1)
        hc = _modulate(_rmsnorm(cs_, norm_attn[l]), sh1c, sc1c)
        qa, ka, va, qb, kb, vb, qc, kc, vc = _qkv_heads(h, w_in[l], q_norm[l], k_norm[l])
        qa_c, ka_c, va_c, qb_c, kb_c, vb_c, qc_c, kc_c, vc_c = _qkv_heads(hc, w_in[l], q_norm[l], k_norm[l])
        qa = _rope(qa, cos, sin); ka = _rope(ka, cos, sin)
        qc = _rope(qc, cos, sin); kc = _rope(kc, cos, sin)
        ya = _global_attn(qa, ka, va, ka_c, va_c)
        yb = _neighbourhood_attn(qb, kb, vb, kb_c, vb_c, rel_pos_bias[l])
        yc = _window_attn(qc, kc, vc, kc_c, vc_c, sink_logits[l])
        x = x + g1 * (jnp.concatenate([ya, yb, yc], axis=-1) @ w_out[l])
        if not last:
            ya_c = _dense_ctx_attn(qa_c, ka_c, va_c)
            yb_c = _dense_ctx_attn(qb_c, kb_c, vb_c)
            yc_c = _dense_ctx_attn(qc_c, kc_c, vc_c, sink_logits[l])
            cs_ = cs_ + g1c * (jnp.concatenate([ya_c, yb_c, yc_c], axis=-1) @ w_out[l])

        x = x + g2 * _sq_relu_mlp(_modulate(_rmsnorm(x, norm_mlp[l]), sh2, sc2), w_up[l], w_down[l])
        if not last:
            cs_ = cs_ + g2c * _sq_relu_mlp(_modulate(_rmsnorm(cs_, norm_mlp[l]), sh2c, sc2c),
                                           w_up[l], w_down[l])
    return x
```

```cpp
#include <hip/hip_runtime.h>
#include <cstdio>
#include <cstdint>

#ifndef MK_PER_PHASE_LAUNCH
#define MK_PER_PHASE_LAUNCH 0
#endif

constexpr int DM = 2048, NB = 2, SEQ = 8192, DEPTH = 4, CTX = 256, DIN = 4608, DFF = 8192;
constexpr int TPB = CTX + SEQ;
constexpr int MT = NB * TPB;
constexpr int MODW = 6 * DM;
constexpr float EPS = 1e-6f;

#define GAS __attribute__((address_space(1)))
#define LAS __attribute__((address_space(3)))
#define CAS __attribute__((address_space(4)))
typedef unsigned short bf16;
typedef float f32x4 __attribute__((ext_vector_type(4)));
typedef unsigned u32x4 __attribute__((ext_vector_type(4)));
typedef unsigned u32x2 __attribute__((ext_vector_type(2)));

__device__ __forceinline__ unsigned f2bf(float f) { unsigned u = __builtin_bit_cast(unsigned, f); return (u + 0x7fffu + ((u >> 16) & 1u)) >> 16; }
__device__ __forceinline__ unsigned pk2(float lo, float hi) { return f2bf(lo) | (f2bf(hi) << 16); }
__device__ __forceinline__ float bf2f(unsigned b) { return __builtin_bit_cast(float, b << 16); }
#define SWZ_XOR(v, x) __builtin_bit_cast(float, __builtin_amdgcn_ds_swizzle(__builtin_bit_cast(int, (v)), 0x1F | ((x) << 10)))
__device__ __forceinline__ float lane_xor16(float v) { return SWZ_XOR(v, 16); }
__device__ __forceinline__ void wave_sum2(float& v, float& w) {
    v += SWZ_XOR(v, 1); w += SWZ_XOR(w, 1); v += SWZ_XOR(v, 2); w += SWZ_XOR(w, 2); v += SWZ_XOR(v, 4); w += SWZ_XOR(w, 4); v += SWZ_XOR(v, 8); w += SWZ_XOR(w, 8); v += SWZ_XOR(v, 16); w += SWZ_XOR(w, 16);
    float a = v, b = v, c = w, d = w; asm volatile("s_nop 1\n\tv_permlane32_swap_b32 %0, %1\n\tv_permlane32_swap_b32 %2, %3\n\ts_nop 1" : "+v"(a), "+v"(b), "+v"(c), "+v"(d));
    v = a + b; w = c + d;
}
__device__ __forceinline__ float wave_sum(float v) {
    v += SWZ_XOR(v, 1); v += SWZ_XOR(v, 2); v += SWZ_XOR(v, 4); v += SWZ_XOR(v, 8); v += SWZ_XOR(v, 16);
    float a = v, b = v; asm volatile("s_nop 1\n\tv_permlane32_swap_b32 %0, %1\n\ts_nop 1" : "+v"(a), "+v"(b));
    return a + b;
}

namespace pg8 {
#define PG8_LAS __attribute__((address_space(3)))
typedef unsigned short bf16_t;
typedef short bf16x8 __attribute__((ext_vector_type(8)));
typedef float f32x4 __attribute__((ext_vector_type(4)));
typedef unsigned u32x4 __attribute__((ext_vector_type(4)));
constexpr int BM = 256, BK = 64, HALF = 128, HTB = HALF * BK * 2, STAGE_BYTES = 8 * HTB, NXCD = 8, WGM = 8;

__host__ __device__ __forceinline__ int lds_byte(int r, int c) { const int st = (r >> 4) * 2 + (c >> 5), rr = r & 15, cc = c & 31, ob = rr * 64 + cc * 2; return st * 1024 + (ob ^ (((ob >> 9) & 1) << 5)); }
__host__ __device__ __forceinline__ void stage_rc(int b, int& R, int& C) { const int st = b / 1024, sb = b % 1024, swz = sb ^ (((sb >> 9) & 1) << 5); R = (st >> 1) * 16 + swz / 64; C = (st & 1) * 32 + (swz % 64) / 2; }
__host__ __device__ __forceinline__ int perm32(int rho) { const int n = rho >> 4, i = rho & 15; return 8 * (i >> 2) + 4 * n + (i & 3); }

struct Unit { int pm, pn, k0, nt, ks; };
struct Gemm { const bf16_t* A; const bf16_t* Bt; int M, N, K, ld; };

struct TileOrder {
    int nM, nN, nwg, G, c, skip, ntk, nsub, S, ntsub, stag;
    __device__ void init(int nM_, int nN_, int G_, int c_, int skip_, int K_) { nM = nM_; nN = nN_; nwg = nM * nN; G = G_; c = c_; skip = skip_; ntk = K_ / BK; nsub = 0; S = 1; ntsub = 0; stag = 0; }
    __device__ void add_ctx_split(int S_) { S = S_; ntsub = ntk / S_; nsub = 2 * nN * S_; stag = (nsub == G) ? 1 : (2 * nsub == G) ? 2 : 0; }
    __device__ void sub_unit(int q, Unit& u) const { u.ks = q % S; const int r = q / S; u.pn = r % nN; u.pm = (r / nN) * 33; u.k0 = u.ks * ntsub * BK; u.nt = ntsub; }
    __device__ bool next(int i, Unit& u) const {
        int ii = i;
        if (stag && (c & 1)) { if (i == 0) { sub_unit(stag == 1 ? c : (c >> 1), u); return true; } ii = i - 1; }
        const long L = (long)ii * G + c;
        if (L >= nwg) { if (stag == 2 || (stag == 1 && (c & 1))) return false; const int q = (int)(L - nwg); if (q >= nsub) return false; sub_unit(q, u); return true; }
        u.k0 = 0; u.nt = ntk; u.ks = -1;
        int wgid = (int)L; { const int q = nwg / NXCD, r = nwg % NXCD, xcd = wgid % NXCD, off = wgid / NXCD; wgid = (xcd < r ? xcd * (q + 1) : r * (q + 1) + (xcd - r) * q) + off; }
        const int nig = WGM * nN, gid = wgid / nig, fm = gid * WGM, gsz = (nM - fm) < WGM ? (nM - fm) : WGM;
        int pm = fm + ((wgid % nig) % gsz); u.pn = (wgid % nig) / gsz;
        if (skip) pm = pm + 1 + (pm >= 32 ? 1 : 0);
        u.pm = pm; return true;
    }
    __device__ __forceinline__ void a_ready(const Unit&) const {}
    __device__ __forceinline__ void done(const Unit&) const {}
};

__device__ __forceinline__ unsigned cvt_pk_bf16(float lo, float hi) { unsigned r; asm volatile("v_cvt_pk_bf16_f32 %0, %1, %2" : "=v"(r) : "v"(lo), "v"(hi)); return r; }

template <int ACT  > struct EpiBf16 {
    static constexpr bool PERM = true, AFTER_DRAIN = false;
    bf16_t* O; int ldc;
    __device__ __forceinline__ void operator()(const f32x4 (&acc)[2][2][4][2], const Unit& u, int wr, int wc, int fr, int fq) const {
        asm volatile("" : "+v"(fr), "+v"(fq));
        const int row0 = u.pm * BM + wr * 64 + fr; const int col0 = u.pn * BM + wc * 32 + 8 * fq;
#pragma unroll
        for (int ai = 0; ai < 2; ++ai)
#pragma unroll
            for (int m = 0; m < 4; ++m) { bf16_t* rowp = O + (size_t)(row0 + ai * HALF + m * 16) * ldc + col0;
#pragma unroll
                for (int bj = 0; bj < 2; ++bj) { f32x4 v0 = acc[ai][bj][m][0], v1 = acc[ai][bj][m][1];
                    if (ACT == 3) {
#pragma unroll
                        for (int j = 0; j < 4; ++j) { const float a = fmaxf(v0[j], 0.f), b = fmaxf(v1[j], 0.f); v0[j] = a * a; v1[j] = b * b; } }
                    u32x4 w; w.x = cvt_pk_bf16(v0[0], v0[1]); w.y = cvt_pk_bf16(v0[2], v0[3]); w.z = cvt_pk_bf16(v1[0], v1[1]); w.w = cvt_pk_bf16(v1[2], v1[3]);
                    *(u32x4*)(rowp + bj * HALF) = w; } }
    }
};
struct EpiQKV {
    static constexpr bool PERM = true, AFTER_DRAIN = false;
    bf16_t* O; const float* qn; const float* kn; const float* rope; PG8_LAS float* P;
    __device__ __forceinline__ void operator()(const f32x4 (&acc)[2][2][4][2], const Unit& u, int wr, int wc, int fr, int fq) const {
        asm volatile("" : "+v"(fr), "+v"(fq));
        const int pn = u.pn;
        const int typ = (pn < 2) ? 0 : (pn == 2) ? 1 : (pn == 3) ? 2 : (pn < 7) ? 0 : (pn < 10) ? 1 : (pn < 13) ? 2 : (pn < 16) ? 0 : (pn == 16) ? 1 : 2;
        const int grp = (pn < 4) ? 0 : (pn < 13) ? 1 : 2;
        const int row0 = u.pm * BM + wr * 64 + fr, col0 = wc * 32 + 8 * fq;
        bf16_t* const Oh = O + ((size_t)(2 * pn) * 16896) * 128; constexpr size_t HSTR = (size_t)16896 * 128;
        if (typ == 2) {
#pragma unroll
            for (int ai = 0; ai < 2; ++ai)
#pragma unroll
                for (int m = 0; m < 4; ++m) { bf16_t* rowp = Oh + (size_t)(row0 + ai * HALF + m * 16) * 128 + col0;
#pragma unroll
                    for (int bj = 0; bj < 2; ++bj) { const f32x4 v0 = acc[ai][bj][m][0], v1 = acc[ai][bj][m][1];
                        u32x4 w; w.x = cvt_pk_bf16(v0[0], v0[1]); w.y = cvt_pk_bf16(v0[2], v0[3]); w.z = cvt_pk_bf16(v1[0], v1[1]); w.w = cvt_pk_bf16(v1[2], v1[3]);
                        *(u32x4*)(rowp + bj * HSTR) = w; } }
            return;
        }
#pragma unroll
        for (int ai = 0; ai < 2; ++ai)
#pragma unroll
            for (int m = 0; m < 4; ++m) { float s0, s1;
                { const f32x4 a = acc[ai][0][m][0], b = acc[ai][0][m][1]; s0 = ((a[0] * a[0] + a[1] * a[1]) + (a[2] * a[2] + a[3] * a[3])) + ((b[0] * b[0] + b[1] * b[1]) + (b[2] * b[2] + b[3] * b[3])); }
                { const f32x4 a = acc[ai][1][m][0], b = acc[ai][1][m][1]; s1 = ((a[0] * a[0] + a[1] * a[1]) + (a[2] * a[2] + a[3] * a[3])) + ((b[0] * b[0] + b[1] * b[1]) + (b[2] * b[2] + b[3] * b[3])); }
                s0 += SWZ_XOR(s0, 16); s1 += SWZ_XOR(s1, 16);
                float a0 = s0, b0 = s0, a1 = s1, b1 = s1; asm volatile("s_nop 1\n\tv_permlane32_swap_b32 %0, %1\n\tv_permlane32_swap_b32 %2, %3\n\ts_nop 1" : "+v"(a0), "+v"(b0), "+v"(a1), "+v"(b1));
                if (fq == 0) { PG8_LAS float* pr = P + (ai * HALF + wr * 64 + m * 16 + fr) * 8 + wc; pr[0] = a0 + b0; pr[4] = a1 + b1; } }
        asm volatile("s_waitcnt lgkmcnt(0)" ::: "memory"); __builtin_amdgcn_s_barrier(); asm volatile("" ::: "memory");
        const int half = wc >> 1, gg = (4 * wc + fq) & 7;
        const float* gnp = ((typ == 0) ? qn : kn) + grp * 128 + half * 64 + gg * 4;
        const f32x4 gA = *(const f32x4*)gnp, gB = *(const f32x4*)(gnp + 32);
        const int b = u.pm / 33, j = u.pm - b * 33;
        const bool roped = (j != 0) && (grp != 1);
        f32x4 tb[4][2];
#pragma unroll
        for (int m = 0; m < 4; ++m) { tb[m][0] = (f32x4){1.f, 0.f, 1.f, 0.f}; tb[m][1] = (f32x4){1.f, 0.f, 1.f, 0.f}; }
        if (roped && half == 1) {
#pragma unroll
            for (int m = 0; m < 4; ++m) { const float* tp = rope + ((16 * m + fr) * 32 + gg * 4) * 2; tb[m][0] = *(const f32x4*)tp; tb[m][1] = *(const f32x4*)(tp + 4); } }
#pragma unroll
        for (int ai = 0; ai < 2; ++ai) {
            if (roped && half == 0) {
                const float* tp = rope + ((4 * (j - 1) + 2 * ai + wr) * 32 + gg * 4) * 2; const f32x4 t0 = *(const f32x4*)tp, t1 = *(const f32x4*)(tp + 4);
#pragma unroll
                for (int m = 0; m < 4; ++m) { tb[m][0] = t0; tb[m][1] = t1; } }
#pragma unroll
            for (int m = 0; m < 4; ++m) { bf16_t* rowp = Oh + (size_t)(row0 + ai * HALF + m * 16) * 128 + col0;
                const PG8_LAS float* pr = P + (ai * HALF + wr * 64 + m * 16 + fr) * 8;
                const f32x4 cvec = {tb[m][0][0], tb[m][0][2], tb[m][1][0], tb[m][1][2]}, svec = {tb[m][0][1], tb[m][0][3], tb[m][1][1], tb[m][1][3]};
#pragma unroll
                for (int bj = 0; bj < 2; ++bj) { const f32x4 pp = *(const PG8_LAS f32x4*)(pr + bj * 4);
                    const float rstd = 1.0f / sqrtf(((pp[0] + pp[1]) + (pp[2] + pp[3])) * (1.0f / 128.0f) + 1e-6f);
                    const f32x4 x0 = acc[ai][bj][m][0] * rstd * gA, x1 = acc[ai][bj][m][1] * rstd * gB;
                    const f32x4 y0 = x0 * cvec - x1 * svec, y1 = x1 * cvec + x0 * svec;
                    u32x4 w; w.x = cvt_pk_bf16(y0[0], y0[1]); w.y = cvt_pk_bf16(y0[2], y0[3]); w.z = cvt_pk_bf16(y1[0], y1[1]); w.w = cvt_pk_bf16(y1[2], y1[3]);
                    *(u32x4*)(rowp + bj * HSTR) = w; } }
        }
    }
};
struct EpiRes {
    static constexpr bool PERM = false, AFTER_DRAIN = false;
    const float* res_lat; const float* res_ctx; float* out_lat; float* out_ctx; const float* gate; float* slab;
    __device__ __forceinline__ void operator()(const f32x4 (&acc)[2][2][4][2], const Unit& u, int wr, int wc, int fr, int fq) const {
        asm volatile("" : "+v"(fr), "+v"(fq));
        const int b = u.pm / 33, j = u.pm - b * 33;
        if (u.ks >= 0) {
            float* sb = slab + ((size_t)(u.ks * 512 + b * 256) * 2048 + u.pn * BM);
            const int row0 = wr * 64 + fr, col0 = wc * 32 + 4 * fq;
#pragma unroll
            for (int ai = 0; ai < 2; ++ai)
#pragma unroll
                for (int m = 0; m < 4; ++m) { const unsigned off = (unsigned)(((row0 + ai * HALF + m * 16) * 2048 + col0) * 4);
#pragma unroll
                    for (int bj = 0; bj < 2; ++bj)
#pragma unroll
                        for (int n = 0; n < 2; ++n) *(f32x4*)((char*)sb + off + (unsigned)((bj * HALF + n * 16) * 4)) = acc[ai][bj][m][n]; }
            return;
        }
        const float* rb; float* ob; const float* gp;
        if (j == 0) { const size_t off = (size_t)(b * 256) * 2048; rb = res_ctx + off; ob = out_ctx + off; gp = gate + 2 * 12288; }
        else { const size_t off = (size_t)(b * 8192 + (j - 1) * 256) * 2048; rb = res_lat + off; ob = out_lat + off; gp = gate + b * 12288; }
        const int row0 = wr * 64 + fr, col0 = wc * 32 + 4 * fq;
        rb += u.pn * BM; ob += u.pn * BM; gp += u.pn * BM;
        f32x4 gv[2][2];
#pragma unroll
        for (int bj = 0; bj < 2; ++bj)
#pragma unroll
            for (int n = 0; n < 2; ++n) gv[bj][n] = *(const f32x4*)((const char*)gp + (unsigned)((col0 + bj * HALF + n * 16) * 4));
#pragma unroll
        for (int ai = 0; ai < 2; ++ai) {
            f32x4 rr[4][2][2];
#pragma unroll
            for (int m = 0; m < 4; ++m) { const unsigned off = (unsigned)(((row0 + ai * HALF + m * 16) * 2048 + col0) * 4);
#pragma unroll
                for (int bj = 0; bj < 2; ++bj)
#pragma unroll
                    for (int n = 0; n < 2; ++n) rr[m][bj][n] = *(const f32x4*)((const char*)rb + off + (unsigned)((bj * HALF + n * 16) * 4)); }
#pragma unroll
            for (int m = 0; m < 4; ++m) { const unsigned off = (unsigned)(((row0 + ai * HALF + m * 16) * 2048 + col0) * 4);
#pragma unroll
                for (int bj = 0; bj < 2; ++bj)
#pragma unroll
                    for (int n = 0; n < 2; ++n) *(f32x4*)((char*)ob + off + (unsigned)((bj * HALF + n * 16) * 4)) = rr[m][bj][n] + gv[bj][n] * acc[ai][bj][m][n]; }
            asm volatile("" ::: "memory"); }
    }
};

template <class Epi, class Sched, bool ALIGN_EPI = false, bool SP2 = false>
__device__ __forceinline__ void gemm_phase(PG8_LAS unsigned char* lds, const Gemm g, const Sched& S, const Epi& E, const int tid) {
    const int wid = __builtin_amdgcn_readfirstlane(tid >> 6), lane = tid & 63, wr = wid >> 2, wc = wid & 3, fr = lane & 15, fq = lane >> 4;
    const int LD = g.ld;
    unsigned voffA[2], voffB[2];
#pragma unroll
    for (int i = 0; i < 2; ++i) { int R, C; stage_rc(tid * 16 + i * 8192, R, C); const int Rb = Epi::PERM ? ((R & ~31) + perm32(R & 31)) : R;
        voffA[i] = (unsigned)(R * LD + C) * 2u; voffB[i] = (unsigned)(Rb * LD + C) * 2u; }
    const size_t kstep = (size_t)(BK * 2);
    const size_t hstep = (size_t)HALF * LD * 2;
    const size_t tstep = 2 * hstep;
    const unsigned ldsw = (unsigned)wid * 1024u;
    const int aoff = lds_byte(wr * 64 + fr, fq * 8), boff = lds_byte(wc * 32 + fr, fq * 8);
#define PG8_SA(b, h) (((b) * 2 + (h)) * HTB)
#define PG8_SB(b, h) ((4 + (b) * 2 + (h)) * HTB)
#define PG8_STAGE(bufoff, gbase, voff) do { _Pragma("unroll") for (int _i = 0; _i < 2; ++_i) \
        __builtin_amdgcn_global_load_lds((const unsigned*)((const char*)(gbase) + (voff)[_i]), (PG8_LAS unsigned*)(lds + (bufoff) + ldsw + _i * 8192), 16, 0, 0); } while (0)
#define PG8_LDA(dst, b, h) do { _Pragma("unroll") for (int m = 0; m < 4; ++m) _Pragma("unroll") for (int k = 0; k < 2; ++k) dst[m][k] = *(const PG8_LAS bf16x8*)(lds + PG8_SA(b, h) + aoff + m * 2048 + k * 1024); } while (0)
#define PG8_LDB(dst, b, h) do { _Pragma("unroll") for (int n = 0; n < 2; ++n) _Pragma("unroll") for (int k = 0; k < 2; ++k) dst[n][k] = *(const PG8_LAS bf16x8*)(lds + PG8_SB(b, h) + boff + n * 2048 + k * 1024); } while (0)
#define PG8_MMA(ai, bj, At, Bt) do { __builtin_amdgcn_s_setprio(1); _Pragma("unroll") for (int m = 0; m < 4; ++m) _Pragma("unroll") for (int n = 0; n < 2; ++n) _Pragma("unroll") for (int k = 0; k < 2; ++k) \
        acc[ai][bj][m][n] = __builtin_amdgcn_mfma_f32_16x16x32_bf16(Bt[n][k], At[m][k], acc[ai][bj][m][n], 0, 0, 0); __builtin_amdgcn_s_setprio(0); } while (0)
#define PG8_WAIT_V(n) asm volatile("s_waitcnt vmcnt(" #n ")" ::: "memory")
#define PG8_WAIT_L(n) asm volatile("s_waitcnt lgkmcnt(" #n ")" ::: "memory")
#define PG8_BAR __builtin_amdgcn_s_barrier()
#define PG8_SCHED __builtin_amdgcn_sched_barrier(0)
    Unit cur, nxt; int ui = 0;
    if (!S.next(0, cur)) return;
    f32x4 acc[2][2][4][2];
#pragma unroll
    for (int a = 0; a < 2; ++a)
#pragma unroll
        for (int b = 0; b < 2; ++b)
#pragma unroll
            for (int m = 0; m < 4; ++m)
#pragma unroll
                for (int n = 0; n < 2; ++n) acc[a][b][m][n] = (f32x4){0.f, 0.f, 0.f, 0.f};
    bf16x8 At[4][2], B0[2][2], B1[2][2];
    const char* cA = (const char*)g.A + (size_t)cur.pm * tstep + (size_t)cur.k0 * 2; const char* cB = (const char*)g.Bt + (size_t)cur.pn * tstep + (size_t)cur.k0 * 2;
    S.a_ready(cur);
    if constexpr (SP2) {
        PG8_STAGE(PG8_SB(0, 0), cB, voffB); PG8_STAGE(PG8_SB(0, 1), cB + hstep, voffB); PG8_STAGE(PG8_SA(0, 0), cA, voffA); PG8_STAGE(PG8_SA(0, 1), cA + hstep, voffA);
        if (wr == 1) PG8_BAR;
        PG8_WAIT_V(2); PG8_BAR;
        PG8_STAGE(PG8_SB(1, 0), cB + kstep, voffB); PG8_STAGE(PG8_SA(1, 0), cA + kstep, voffA); PG8_STAGE(PG8_SB(1, 1), cB + hstep + kstep, voffB);
        PG8_WAIT_V(6); PG8_BAR;
    } else {
        PG8_STAGE(PG8_SB(0, 0), cB, voffB); PG8_STAGE(PG8_SA(0, 0), cA, voffA); PG8_STAGE(PG8_SB(0, 1), cB + hstep, voffB); PG8_STAGE(PG8_SA(0, 1), cA + hstep, voffA);
        if (wr == 1) PG8_BAR;
        PG8_WAIT_V(4); PG8_BAR;
        PG8_STAGE(PG8_SB(1, 0), cB + kstep, voffB); PG8_STAGE(PG8_SA(1, 0), cA + kstep, voffA); PG8_STAGE(PG8_SB(1, 1), cB + hstep + kstep, voffB);
        PG8_WAIT_V(6); PG8_BAR;
    }
    for (;;) {
        const bool has_next = S.next(ui + 1, nxt);
        const char* nA = has_next ? (const char*)g.A + (size_t)nxt.pm * tstep + (size_t)nxt.k0 * 2 : cA; const char* nB = has_next ? (const char*)g.Bt + (size_t)nxt.pn * tstep + (size_t)nxt.k0 * 2 : cB;
        const int nt = cur.nt;
        for (int t = 0; t < nt; t += 2) {
            const bool last = (t == nt - 2);
            const char* a1 = cA + (size_t)(t + 1) * kstep;
            const char* a2 = last ? nA : cA + (size_t)(t + 2) * kstep; const char* b2 = last ? nB : cB + (size_t)(t + 2) * kstep;
            const char* a3 = a2 + kstep; const char* b3 = b2 + kstep;
            if (last && has_next) S.a_ready(nxt);
            if constexpr (SP2) {
            PG8_LDB(B0, 0, 0); PG8_LDB(B1, 0, 1); PG8_SCHED; PG8_LDA(At, 0, 0); PG8_STAGE(PG8_SA(1, 1), a1 + hstep, voffA);
            PG8_WAIT_V(8); PG8_WAIT_L(0); PG8_BAR; PG8_MMA(0, 0, At, B0); PG8_MMA(0, 1, At, B1); PG8_BAR; PG8_SCHED;
            PG8_LDA(At, 0, 1); PG8_STAGE(PG8_SB(0, 0), b2, voffB); PG8_STAGE(PG8_SB(0, 1), b2 + hstep, voffB); PG8_STAGE(PG8_SA(0, 0), a2, voffA);
            PG8_WAIT_V(8); PG8_WAIT_L(0); PG8_BAR; PG8_MMA(1, 0, At, B0); PG8_MMA(1, 1, At, B1); PG8_BAR; PG8_SCHED;
            PG8_LDB(B0, 1, 0); PG8_LDB(B1, 1, 1); PG8_SCHED; PG8_LDA(At, 1, 0); PG8_STAGE(PG8_SA(0, 1), a2 + hstep, voffA);
            PG8_WAIT_V(8); PG8_WAIT_L(0); PG8_BAR; PG8_MMA(0, 0, At, B0); PG8_MMA(0, 1, At, B1); PG8_BAR; PG8_SCHED;
            PG8_LDA(At, 1, 1); PG8_STAGE(PG8_SB(1, 0), b3, voffB); PG8_STAGE(PG8_SB(1, 1), b3 + hstep, voffB); PG8_STAGE(PG8_SA(1, 0), a3, voffA);
            PG8_WAIT_V(8); PG8_WAIT_L(0); PG8_BAR; PG8_MMA(1, 0, At, B0); PG8_MMA(1, 1, At, B1); PG8_BAR; PG8_SCHED;
            } else {
            PG8_LDB(B0, 0, 0); PG8_SCHED; PG8_LDA(At, 0, 0); PG8_STAGE(PG8_SA(1, 1), a1 + hstep, voffA);
            PG8_WAIT_L(8); PG8_BAR; PG8_WAIT_L(0); PG8_MMA(0, 0, At, B0); PG8_BAR; PG8_SCHED;
            PG8_LDB(B1, 0, 1); PG8_STAGE(PG8_SB(0, 0), b2, voffB);
            PG8_BAR; PG8_WAIT_L(0); PG8_MMA(0, 1, At, B1); PG8_BAR;
            PG8_LDA(At, 0, 1); PG8_STAGE(PG8_SA(0, 0), a2, voffA);
            PG8_BAR; PG8_WAIT_L(0); PG8_MMA(1, 0, At, B0); PG8_BAR; PG8_SCHED;
            PG8_STAGE(PG8_SB(0, 1), b2 + hstep, voffB);
            PG8_WAIT_V(6); PG8_BAR; PG8_MMA(1, 1, At, B1); PG8_BAR;
            PG8_LDB(B0, 1, 0); PG8_SCHED; PG8_LDA(At, 1, 0); PG8_STAGE(PG8_SA(0, 1), a2 + hstep, voffA);
            PG8_WAIT_L(8); PG8_BAR; PG8_WAIT_L(0); PG8_MMA(0, 0, At, B0); PG8_BAR; PG8_SCHED;
            PG8_LDB(B1, 1, 1); PG8_STAGE(PG8_SB(1, 0), b3, voffB);
            PG8_BAR; PG8_WAIT_L(0); PG8_MMA(0, 1, At, B1); PG8_BAR;
            PG8_LDA(At, 1, 1); PG8_STAGE(PG8_SA(1, 0), a3, voffA);
            PG8_BAR; PG8_WAIT_L(0); PG8_MMA(1, 0, At, B0); PG8_BAR; PG8_SCHED;
            PG8_STAGE(PG8_SB(1, 1), b3 + hstep, voffB);
            PG8_WAIT_V(6); PG8_BAR; PG8_MMA(1, 1, At, B1); PG8_BAR;
            }
        }
        if constexpr (ALIGN_EPI) { if (wr == 0) PG8_BAR; }
        if constexpr (!Epi::AFTER_DRAIN) { E(acc, cur, wr, wc, fr, fq); S.done(cur); }
        if (!has_next) break;
#pragma unroll
        for (int a = 0; a < 2; ++a)
#pragma unroll
            for (int b = 0; b < 2; ++b)
#pragma unroll
                for (int m = 0; m < 4; ++m)
#pragma unroll
                    for (int n = 0; n < 2; ++n) acc[a][b][m][n] = (f32x4){0.f, 0.f, 0.f, 0.f};
        cur = nxt; cA = nA; cB = nB; ++ui;
        if constexpr (ALIGN_EPI) { if (wr == 1) PG8_BAR; }
    }
    PG8_WAIT_V(0);
    if constexpr (!ALIGN_EPI) { if (wr == 0) PG8_BAR; }
    PG8_BAR;
#undef PG8_SA
#undef PG8_SB
#undef PG8_STAGE
#undef PG8_LDA
#undef PG8_LDB
#undef PG8_MMA
#undef PG8_WAIT_V
#undef PG8_WAIT_L
#undef PG8_BAR
#undef PG8_SCHED
}
}

namespace att {
typedef short bf16x8 __attribute__((ext_vector_type(8)));
typedef short s16x4 __attribute__((ext_vector_type(4)));
typedef float f32x16 __attribute__((ext_vector_type(16)));
constexpr int D = 128, NW = 8, QBLK = 32, KVBLK = 64;
constexpr float SCALE = 0.088388347648318440f;
constexpr float THR = 8.f;
constexpr int LDQK = 128, LDO = DM;
constexpr int SHM_V = KVBLK * D * 2, SHM_K = KVBLK * D * 2;
constexpr int OFF_WS = 2 * SHM_V + 2 * SHM_K;
constexpr int OFF_RPB = OFF_WS + NW * 64 * 4 + 1024;
constexpr int OFF_Q = OFF_RPB + 2048 + 1024;
constexpr int ATT_LDS = OFF_Q + 65536;
#define KSWZ(row, colB) ((row) * 256 + ((colB) ^ (((row) & 7) << 4)))
#define SBAR() __builtin_amdgcn_sched_barrier(0)
__device__ __forceinline__ int crow(int r, int hi) { return (r & 3) + 8 * (r >> 2) + 4 * hi; }
__device__ __forceinline__ unsigned cvtpk(float lo, float hi) { unsigned r; asm volatile("v_cvt_pk_bf16_f32 %0, %1, %2" : "=v"(r) : "v"(lo), "v"(hi)); return r; }

__device__ __forceinline__ void partialSM(f32x16& p0, f32x16& p1, float& m_reg, float& mn, float& alpha) {
  constexpr float C = SCALE * 1.4426950408889634f;
  float pmax = p0[0]; for (int r = 1; r < 16; ++r) pmax = fmaxf(pmax, p0[r]); for (int r = 0; r < 16; ++r) pmax = fmaxf(pmax, p1[r]);
  { auto rr = __builtin_amdgcn_permlane32_swap(__float_as_uint(pmax), __float_as_uint(pmax), false, false);
    pmax = fmaxf(__uint_as_float(rr[0]), __uint_as_float(rr[1])); }
  if (__builtin_expect(__all(pmax - m_reg <= THR / SCALE), 1)) { mn = m_reg; alpha = 1.f; }
  else { mn = fmaxf(m_reg, pmax); alpha = __builtin_amdgcn_exp2f((m_reg - mn) * C); m_reg = mn; }
  float mnC = -mn * C;
  for (int r = 0; r < 16; ++r) p0[r] = fmaf(p0[r], C, mnC); for (int r = 0; r < 16; ++r) p1[r] = fmaf(p1[r], C, mnC);
  for (int r = 0; r < 16; ++r) p0[r] = __builtin_amdgcn_exp2f(p0[r]);
}
__device__ __forceinline__ void finishSM(f32x16& p0, f32x16& p1, float alpha, float& l_reg, bf16x8& pa0, bf16x8& pa1, bf16x8& pa2, bf16x8& pa3) {
  for (int r = 0; r < 16; ++r) p1[r] = __builtin_amdgcn_exp2f(p1[r]);
  float ps = 0; for (int r = 0; r < 16; ++r) ps += p0[r]; for (int r = 0; r < 16; ++r) ps += p1[r];
  { auto rr = __builtin_amdgcn_permlane32_swap(__float_as_uint(ps), __float_as_uint(ps), false, false);
    ps = __uint_as_float(rr[0]) + __uint_as_float(rr[1]); }
  l_reg = l_reg * alpha + ps;
#define PK4(P, BASE, OUT) do { unsigned a0 = cvtpk(P[BASE + 0], P[BASE + 1]), a1 = cvtpk(P[BASE + 2], P[BASE + 3]);   \
    unsigned b0 = cvtpk(P[BASE + 4], P[BASE + 5]), b1 = cvtpk(P[BASE + 6], P[BASE + 7]);                              \
    auto r0 = __builtin_amdgcn_permlane32_swap(a0, b0, false, false); auto r1 = __builtin_amdgcn_permlane32_swap(a1, b1, false, false); \
    u32x4 w = {r0[0], r1[0], r0[1], r1[1]}; OUT = *reinterpret_cast<bf16x8*>(&w); } while (0)
  PK4(p0, 0, pa0); PK4(p0, 8, pa1); PK4(p1, 0, pa2); PK4(p1, 8, pa3);
#undef PK4
}
template <int QR>
__device__ __forceinline__ void qkt(f32x16& p0, f32x16& p1, const char* Ks, const bf16x8* qr, const char* qsl, int r32, int hi) {
  p0 = f32x16{}; p1 = f32x16{};
#pragma unroll
  for (int d0 = 0; d0 < 8; ++d0) { int cb = (d0 * 16 + hi * 8) * 2;
    bf16x8 b0 = *reinterpret_cast<const bf16x8*>(Ks + KSWZ(r32, cb));
    bf16x8 b1 = *reinterpret_cast<const bf16x8*>(Ks + KSWZ(32 + r32, cb));
    const bf16x8 q = (d0 < QR) ? qr[d0 < QR ? d0 : 0] : *reinterpret_cast<const bf16x8*>(qsl + d0 * 1024);
    p0 = __builtin_amdgcn_mfma_f32_32x32x16_bf16(b0, q, p0, 0, 0, 0);
    p1 = __builtin_amdgcn_mfma_f32_32x32x16_bf16(b1, q, p1, 0, 0, 0); }
}
__device__ __forceinline__ int v_st(int k, int c) { const int kk = (k & ~0xC) | ((k & 4) << 1) | ((k & 8) >> 1); return ((kk >> 3) * 4 + (c >> 5)) * 512 + ((kk & 7) * 32 + (c & 31)) * 2; }
__device__ __forceinline__ int v_rd_base(int lane) { return ((lane & 3) << 3) | (((lane >> 2) & 3) << 6) | (((lane >> 4) & 1) << 5) | (((lane >> 5) & 1) << 8); }
constexpr int v_rd_off(int d0, int ks, int half) { return d0 * 512 + ks * 4096 + half * 2048; }
template <int OFF> __device__ __forceinline__ s16x4 tr_read(int vb) {
  s16x4 r; asm volatile("ds_read_b64_tr_b16 %0, %1 offset:%2" : "=&v"(r) : "v"(vb), "i"(OFF) : "memory"); return r;
}
template <int D0> __device__ __forceinline__ void pv_one(f32x16& od, int vb, bf16x8 pa0, bf16x8 pa1, bf16x8 pa2, bf16x8 pa3) {
  const s16x4 l0 = tr_read<v_rd_off(D0, 0, 0)>(vb), h0 = tr_read<v_rd_off(D0, 0, 1)>(vb), l1 = tr_read<v_rd_off(D0, 1, 0)>(vb), h1 = tr_read<v_rd_off(D0, 1, 1)>(vb);
  const s16x4 l2 = tr_read<v_rd_off(D0, 2, 0)>(vb), h2 = tr_read<v_rd_off(D0, 2, 1)>(vb), l3 = tr_read<v_rd_off(D0, 3, 0)>(vb), h3 = tr_read<v_rd_off(D0, 3, 1)>(vb);
  asm volatile("s_waitcnt lgkmcnt(0)" ::: "memory"); SBAR();
#define PK(L, H) (bf16x8){L[0], L[1], L[2], L[3], H[0], H[1], H[2], H[3]}
  od = __builtin_amdgcn_mfma_f32_32x32x16_bf16(pa0, PK(l0, h0), od, 0, 0, 0);
  od = __builtin_amdgcn_mfma_f32_32x32x16_bf16(pa1, PK(l1, h1), od, 0, 0, 0);
  od = __builtin_amdgcn_mfma_f32_32x32x16_bf16(pa2, PK(l2, h2), od, 0, 0, 0);
  od = __builtin_amdgcn_mfma_f32_32x32x16_bf16(pa3, PK(l3, h3), od, 0, 0, 0);
#undef PK
}
__device__ __forceinline__ void pv_d0(f32x16* o, int vb, bf16x8 pa0, bf16x8 pa1, bf16x8 pa2, bf16x8 pa3) {
  pv_one<0>(o[0], vb, pa0, pa1, pa2, pa3); pv_one<1>(o[1], vb, pa0, pa1, pa2, pa3); pv_one<2>(o[2], vb, pa0, pa1, pa2, pa3); pv_one<3>(o[3], vb, pa0, pa1, pa2, pa3);
}

template <int MASK>
__device__ __forceinline__ void apply_mask(f32x16& p0, f32x16& p1, int jt, int NTR, int lat_t0, int q0lat, int wid, int r32, int hi, const float* rpbs) {
  if constexpr (MASK == 0) return;
  if (jt < 4) return;
  constexpr float NEG = -1e30f;
  if (jt >= NTR) {
#pragma unroll
    for (int r = 0; r < 16; ++r) { p0[r] = NEG; p1[r] = NEG; }
    return; }
  const int tl = lat_t0 + jt - 4;
  if constexpr (MASK == 1) {
    const int qw = q0lat + wid * 32, kp0 = tl * 64;
    if (kp0 + 63 - qw <= 128 && kp0 - (qw + 31) >= -128) return;
    int base = kp0 + 4 * hi - (qw + r32); asm volatile("" : "+v"(base));
#pragma unroll
    for (int r = 0; r < 16; ++r) { const int dk = base + (r & 3) + 8 * (r >> 2), dk1 = dk + 32;
      p0[r] = (dk > 128 || dk < -128) ? NEG : p0[r]; p1[r] = (dk1 > 128 || dk1 < -128) ? NEG : p1[r]; }
  } else {
    const int qr = (q0lat >> 6) + (wid >> 1), qc = (wid & 1) * 32 + r32;
    const int rs = min(max(qr - 4, 0), 120);
    if (tl < rs || tl >= rs + 8) {
#pragma unroll
      for (int r = 0; r < 16; ++r) { p0[r] = NEG; p1[r] = NEG; }
      return; }
    const int cs = min(max(qc - 8, 0), 48);
    int boff = ((tl - qr + 7) * 31 + (15 - qc) + 4 * hi) * 4; int d = 4 * hi - cs; asm volatile("" : "+v"(boff), "+v"(d));
    const volatile LAS float* brow = (const volatile LAS float*)((const LAS char*)rpbs + boff);
#pragma unroll
    for (int g = 0; g < 4; ++g) {
      float b0[4], b1[4];
#pragma unroll
      for (int j = 0; j < 4; ++j) { b0[j] = brow[8 * g + j]; b1[j] = brow[8 * g + j + 32]; }
#pragma unroll
      for (int j = 0; j < 4; ++j) { const int r = 4 * g + j, t0 = d + 8 * g + j, t1 = t0 + 32;
        p0[r] = ((unsigned)t0 < 16u) ? p0[r] + b0[j] : NEG; p1[r] = ((unsigned)t1 < 16u) ? p1[r] + b1[j] : NEG; }
      SBAR();
    }
  }
}

template <int MASK, int QR, int NBUF>
__device__ __forceinline__ void attn_unit(const bf16* __restrict__ Qb, const bf16* __restrict__ Kb, const bf16* __restrict__ Vb, bf16* __restrict__ Ob,
                                          int NT, int NTR, int lat_t0, int q0lat, float sink_l2, char* lds, const int tid) {
  const int wid = __builtin_amdgcn_readfirstlane(tid >> 6), lane = tid & 63, r32 = lane & 31, hi = lane >> 5;
  static_assert(NBUF == 2 || (NBUF == 3 && MASK == 0), "the 3-deep ring overlays the bias region of LDS: dense units only");
  char* V_lds = lds; char* K_lds = lds + NBUF * SHM_V;
  float* ws = (float*)(lds + NBUF * (SHM_V + SHM_K)) + wid * 64; float* li_l = ws; float* al_l = ws + 32;
  const float* rpbs = (const float*)(lds + OFF_RPB);
  float m_reg = -1e30f, l_reg = 0; f32x16 o[4] = {}; bf16x8 qr[QR > 0 ? QR : 1];
  char* qsl = lds + (NBUF == 3 ? 100352 : OFF_Q) + wid * ((8 - QR) * 1024) + lane * 16 - QR * 1024;
  { const unsigned qoff = (unsigned)(((wid * QBLK + r32) * LDQK + hi * 8) * 2);
#pragma unroll
    for (int d0 = 0; d0 < 8; ++d0) { const bf16x8 q = *reinterpret_cast<const bf16x8*>((const char*)Qb + qoff + d0 * 32);
      if (d0 < QR) qr[d0 < QR ? d0 : 0] = q; else *reinterpret_cast<bf16x8*>(qsl + d0 * 1024) = q; } }
  const int sr = tid >> 4, sc = (tid & 15) * 8, vst0 = v_st(sr, sc), vst1 = v_st(32 + sr, sc);
  const int vb0 = (int)(uintptr_t)V_lds + v_rd_base(lane);
  const unsigned ldoff0 = (unsigned)((sr * LDQK + sc) * 2), ldoff1 = ldoff0 + (unsigned)(32 * LDQK * 2);
  struct { bf16x8 vs0, vs1, ks0, ks1; } sr_[2];
#define KROW(jt) ((jt) >= NTR ? 0 : ((jt) < 4 ? 64 * (jt) : 256 + 64 * (lat_t0 + (jt) - 4)))
#define SLOAD(i, jt) do { const size_t kb_ = (size_t)(KROW(jt)) * (LDQK * 2); const char* vt_ = (const char*)Vb + kb_; const char* kt_ = (const char*)Kb + kb_; \
    sr_[i].vs0 = *reinterpret_cast<const bf16x8*>(vt_ + ldoff0); sr_[i].vs1 = *reinterpret_cast<const bf16x8*>(vt_ + ldoff1); \
    sr_[i].ks0 = *reinterpret_cast<const bf16x8*>(kt_ + ldoff0); sr_[i].ks1 = *reinterpret_cast<const bf16x8*>(kt_ + ldoff1); } while (0)
#define SWRITE(b, i) do { *(bf16x8*)(V_lds + (b) * SHM_V + vst0) = sr_[i].vs0;          \
    *(bf16x8*)(V_lds + (b) * SHM_V + vst1) = sr_[i].vs1; int kc = sc * 2;               \
    *(bf16x8*)(K_lds + (b) * SHM_K + KSWZ(sr, kc)) = sr_[i].ks0;                       \
    *(bf16x8*)(K_lds + (b) * SHM_K + KSWZ(32 + sr, kc)) = sr_[i].ks1; } while (0)
#define SWAIT() asm volatile("s_waitcnt vmcnt(4)" ::: "memory")
#define RESC(a) do { if (__any((a) < 1.f)) { if (hi == 0) al_l[r32] = (a); asm volatile("s_waitcnt lgkmcnt(0)" ::: "memory"); \
    for (int d = 0; d < 4; ++d) for (int r = 0; r < 16; ++r) o[d][r] *= al_l[crow(r, hi)]; } } while (0)
  f32x16 pA0, pA1, pB0, pB1; float mnA, mnB, alA, alB; bf16x8 pa0, pa1, pa2, pa3;
  constexpr int SE = 0, SO = 1;
  const int qw_ = q0lat + wid * 32, qr_ = (q0lat >> 6) + (wid >> 1), rs_ = min(max(qr_ - 4, 0), 120);
#define NEED(jt) (MASK == 0 || (jt) < 4 || ((jt) < NTR && (MASK == 1 ? ((lat_t0 + (jt) - 4) * 64 + 63 >= qw_ - 128 && (lat_t0 + (jt) - 4) * 64 <= qw_ + 31 + 128) \
                                                                   : (lat_t0 + (jt) - 4 >= rs_ && lat_t0 + (jt) - 4 < rs_ + 8))))
  bool nA = true, nB = true;
  SLOAD(SE, 0); asm volatile("s_waitcnt vmcnt(0)" ::: "memory"); SWRITE(0, SE); __syncthreads();
  qkt<QR>(pA0, pA1, K_lds, qr, qsl, r32, hi); partialSM(pA0, pA1, m_reg, mnA, alA);
  SLOAD(SO, 1); if (2 < NT) SLOAD(SE, 2);
  SWAIT(); SWRITE(1, SO); __syncthreads();
#define STEP2(j, a, b, c) do { \
    nB = NEED(j); \
    SBAR(); if (nB) { qkt<QR>(pB0, pB1, K_lds + (b) * SHM_K, qr, qsl, r32, hi); apply_mask<MASK>(pB0, pB1, (j), NTR, lat_t0, q0lat, wid, r32, hi, rpbs); } \
    if (nA) finishSM(pA0, pA1, alA, l_reg, pa0, pa1, pa2, pa3); SBAR(); \
    SLOAD(SO, (j) + 2); SBAR(); \
    if (nA) pv_d0(o, vb0 + (a) * (int)SHM_V, pa0, pa1, pa2, pa3); \
    if (nB) partialSM(pB0, pB1, m_reg, mnB, alB); else alB = 1.f; \
    if (NBUF == 2) __syncthreads(); \
    SWAIT(); SWRITE((c), SE); \
    RESC(alB); __syncthreads(); \
    nA = NEED((j) + 1); \
    SBAR(); if (nA) { qkt<QR>(pA0, pA1, K_lds + (c) * SHM_K, qr, qsl, r32, hi); apply_mask<MASK>(pA0, pA1, (j) + 1, NTR, lat_t0, q0lat, wid, r32, hi, rpbs); } \
    if (nB) finishSM(pB0, pB1, alB, l_reg, pa0, pa1, pa2, pa3); SBAR(); \
    if ((j) + 3 < NT) SLOAD(SE, (j) + 3); SBAR(); \
    if (nB) pv_d0(o, vb0 + (b) * (int)SHM_V, pa0, pa1, pa2, pa3); \
    if (nA) partialSM(pA0, pA1, m_reg, mnA, alA); else alA = 1.f; \
    if (NBUF == 2) __syncthreads(); \
    SWAIT(); SWRITE((NBUF == 2 ? (b) : (a)), SO); \
    RESC(alA); __syncthreads(); } while (0)
#define TAIL(x, y) do { \
    nB = NEED(NT - 1); \
    SBAR(); if (nB) { qkt<QR>(pB0, pB1, K_lds + (y) * SHM_K, qr, qsl, r32, hi); apply_mask<MASK>(pB0, pB1, NT - 1, NTR, lat_t0, q0lat, wid, r32, hi, rpbs); } \
    if (nA) finishSM(pA0, pA1, alA, l_reg, pa0, pa1, pa2, pa3); SBAR(); \
    if (nA) pv_d0(o, vb0 + (x) * (int)SHM_V, pa0, pa1, pa2, pa3); \
    if (nB) partialSM(pB0, pB1, m_reg, mnB, alB); else alB = 1.f; \
    __syncthreads(); RESC(alB); \
    if (nB) { finishSM(pB0, pB1, alB, l_reg, pa0, pa1, pa2, pa3); SBAR(); \
      pv_d0(o, vb0 + (y) * (int)SHM_V, pa0, pa1, pa2, pa3); } } while (0)
  if constexpr (NBUF == 2) { for (int j = 1; j + 1 < NT; j += 2) STEP2(j, 0, 1, 0); TAIL(0, 1); }
  else { int ba = 0, bb = 1, bc = 2;
    for (int j = 1; j + 1 < NT; j += 2) { STEP2(j, ba, bb, bc); const int t = ba; ba = bc; bc = bb; bb = t; }
    TAIL(ba, bb); }
#undef STEP2
#undef TAIL
#undef NEED
  { constexpr float C = SCALE * 1.4426950408889634f; l_reg += __builtin_amdgcn_exp2f(sink_l2 - m_reg * C); }
  if (hi == 0) li_l[r32] = l_reg; asm volatile("s_waitcnt lgkmcnt(0)" ::: "memory");
  float rli[16];
#pragma unroll
  for (int r = 0; r < 16; ++r) rli[r] = 1.0f / li_l[crow(r, hi)];
  { int r32e = r32, hie = hi; asm volatile("" : "+v"(r32e), "+v"(hie));
    const unsigned ooff = (unsigned)(((wid * QBLK + 4 * hie) * LDO + r32e) * 2);
#pragma unroll
    for (int r = 0; r < 16; ++r) { const unsigned ro = ooff + (unsigned)((((r & 3) + 8 * (r >> 2)) * LDO) * 2);
#pragma unroll
      for (int d0 = 0; d0 < 4; ++d0) *(bf16*)((char*)Ob + ro + d0 * 64) = (bf16)f2bf(o[d0][r] * rli[r]); } }
  __syncthreads();
#undef KROW
#undef SLOAD
#undef SWRITE
#undef SWAIT
#undef RESC
}
}

#define XB_TMO      128
#define XB_XCNT(j)  (256  + 64 * (j))
#define XB_XSUB(j)  (1280 + 64 * (j))
#define XB_XGEN(j)  (2304 + 64 * (j))
#define XB_TOP      3328
#define XB_TOPGEN   3392
#define XCD_BAR_WORDS 3456
#define XB_SPIN_CAP (1u << 18)

__device__ __forceinline__ unsigned xb_ld(unsigned* p)              { return __hip_atomic_load(p, __ATOMIC_RELAXED, __HIP_MEMORY_SCOPE_AGENT); }
__device__ __forceinline__ unsigned xb_add(unsigned* p, unsigned v) { return __hip_atomic_fetch_add(p, v, __ATOMIC_RELAXED, __HIP_MEMORY_SCOPE_AGENT); }
__device__ __forceinline__ unsigned xb_xcc_id() { return (unsigned)__builtin_amdgcn_s_getreg((3 << 11) | 20) & 0xFu; }
#define XB_SPIN(cond, bar) do { unsigned _sp = 0; while (cond) { __builtin_amdgcn_s_sleep(1); \
    if ((++_sp & 255u) == 0u) { if (xb_ld(&(bar)[XB_TMO])) break; if (_sp > XB_SPIN_CAP) { atomicAdd(&(bar)[XB_TMO], 1u); break; } } } } while (0)

struct XcdBarrier { unsigned* bar; unsigned x; volatile LAS unsigned* st; };

__device__ __forceinline__ XcdBarrier xcd_barrier_post(unsigned* bar, volatile LAS unsigned* st) {
    XcdBarrier b; b.bar = bar; b.x = xb_xcc_id(); b.st = st;
    if (threadIdx.x == 0) (void)xb_add(&bar[XB_XCNT(b.x)], 1u);
    return b;
}
__device__ __forceinline__ void xcd_barrier_complete(unsigned* bar, unsigned x, unsigned& nloc, unsigned& nx) {
    const unsigned G = gridDim.x * gridDim.y * gridDim.z;
    unsigned sum, cnt, mine, sp = 0u;
    for (;;) {
        sum = 0u; cnt = 0u; mine = 0u;
#pragma unroll
        for (unsigned j = 0; j < 16; ++j) { const unsigned c = xb_ld(&bar[XB_XCNT(j)]); sum += c; cnt += (c > 0u) ? 1u : 0u; mine = (j == x) ? c : mine; }
        if (sum == G) break;
        __builtin_amdgcn_s_sleep(1);
        if ((++sp & 255u) == 0u) { if (xb_ld(&bar[XB_TMO])) break; if (sp > XB_SPIN_CAP) { atomicAdd(&bar[XB_TMO], 1u); break; } }
    }
    nloc = mine > 0u ? mine : 1u; nx = cnt > 0u ? cnt : 1u;
}
__device__ __forceinline__ void xcd_barrier(const XcdBarrier& b) {
    asm volatile("s_waitcnt vmcnt(0)" ::: "memory");
    __syncthreads();
    if (threadIdx.x == 0) {
        unsigned* bar = b.bar;
        __builtin_amdgcn_s_waitcnt(0);
        unsigned nloc = b.st[0], nx = b.st[1];
        if (nloc == 0u) { xcd_barrier_complete(bar, b.x, nloc, nx); b.st[0] = nloc; b.st[1] = nx; }
        const unsigned old = xb_add(&bar[XB_XSUB(b.x)], 1u);
        const unsigned gen = old / nloc;
        if (old + 1u == (gen + 1u) * nloc) {
            __builtin_amdgcn_fence(__ATOMIC_RELEASE, "agent");
            asm volatile("s_waitcnt vmcnt(0)" ::: "memory");
            const unsigned og = xb_add(&bar[XB_TOP], 1u);
            const unsigned tg = og / nx;
            if (og + 1u == (tg + 1u) * nx) xb_add(&bar[XB_TOPGEN], 1u);
            else XB_SPIN(xb_ld(&bar[XB_TOPGEN]) == tg, bar);
            __builtin_amdgcn_fence(__ATOMIC_ACQUIRE, "agent");
            xb_add(&bar[XB_XGEN(b.x)], 1u);
            asm volatile("s_waitcnt vmcnt(0)" ::: "memory");
        } else {
            XB_SPIN(xb_ld(&bar[XB_XGEN(b.x)]) == gen, bar);
            __builtin_amdgcn_fence(__ATOMIC_ACQUIRE, "agent");
            asm volatile("s_waitcnt vmcnt(0)" ::: "memory");
        }
    }
    __syncthreads();
}

constexpr size_t MiB = 1u << 20;
constexpr size_t WS_CTL = 0, CTL_ZERO_BYTES = 1 * MiB;
constexpr size_t WS_MOD = 1 * MiB;
constexpr size_t WS_MODP = 2 * MiB;
constexpr size_t WS_ROPE = 7 * MiB;
constexpr size_t WS_GV = 7 * MiB + 512 * 1024;
constexpr size_t WS_CS = 8 * MiB;
constexpr size_t WS_W = 12 * MiB;
constexpr size_t W_IN_B = (size_t)DIN * DM * 2, W_OUT_B = (size_t)DM * DM * 2, W_UP_B = (size_t)DFF * DM * 2, W_DOWN_B = (size_t)DM * DFF * 2;
constexpr size_t W_LAYER_B = W_IN_B + W_OUT_B + W_UP_B + W_DOWN_B;
constexpr size_t WS_H = WS_W + DEPTH * W_LAYER_B;
constexpr size_t WS_QKV = WS_H + 66 * MiB;
constexpr size_t WS_Y = WS_QKV + 149 * MiB;
constexpr size_t WS_HID = WS_Y + 66 * MiB;
constexpr size_t WS_SLAB = WS_HID + 264 * MiB;
constexpr size_t WS_END = WS_SLAB + 64 * MiB;
static_assert((size_t)MT * DM * 2 <= 66 * MiB && (size_t)MT * DIN * 2 <= 149 * MiB && (size_t)MT * DFF * 2 <= 264 * MiB, "ws map");
constexpr int CW_BAR = 4096;

constexpr int RING_BYTES = 131072;
constexpr int LDS_BYTES = 163840;
constexpr int MISC_OFF = LDS_BYTES - 1024;
static_assert(att::ATT_LDS <= MISC_OFF && RING_BYTES <= MISC_OFF, "LDS map");

__device__ const float ROPE_INV[32] = {
    1.000000000e+00f, 7.498942614e-01f, 5.623413324e-01f, 4.216965139e-01f, 3.162277639e-01f, 2.371373773e-01f, 1.778279394e-01f, 1.333521307e-01f,
    1.000000015e-01f, 7.498941571e-02f, 5.623413250e-02f, 4.216965288e-02f, 3.162277490e-02f, 2.371373773e-02f, 1.778279431e-02f, 1.333521493e-02f,
    9.999999776e-03f, 7.498941850e-03f, 5.623413250e-03f, 4.216964822e-03f, 3.162277630e-03f, 2.371373586e-03f, 1.778279431e-03f, 1.333521446e-03f,
    1.000000047e-03f, 7.498942432e-04f, 5.623413017e-04f, 4.216965172e-04f, 3.162277571e-04f, 2.371373703e-04f, 1.778279402e-04f, 1.333521504e-04f };

__device__ __forceinline__ void sincos_d(double x, double& s, double& c) {
    const double kd = __builtin_rint(x * 0.63661977236758134308); const int k = (int)kd;
    double r = __builtin_fma(-kd, 1.57079632679489655800e+00, x); r = __builtin_fma(-kd, 6.12323399573676603587e-17, r);
    const double z = r * r;
    double sp = -1.0 / 355687428096000.0;
    sp = sp * z + 1.0 / 1307674368000.0; sp = sp * z - 1.0 / 6227020800.0; sp = sp * z + 1.0 / 39916800.0; sp = sp * z - 1.0 / 362880.0; sp = sp * z + 1.0 / 5040.0; sp = sp * z - 1.0 / 120.0; sp = sp * z + 1.0 / 6.0;
    const double sn = r - r * z * sp;
    double cp = 1.0 / 20922789888000.0;
    cp = cp * z - 1.0 / 87178291200.0; cp = cp * z + 1.0 / 479001600.0; cp = cp * z - 1.0 / 3628800.0; cp = cp * z + 1.0 / 40320.0; cp = cp * z - 1.0 / 720.0; cp = cp * z + 1.0 / 24.0; cp = cp * z - 0.5;
    const double cs = 1.0 + z * cp;
    switch (k & 3) { case 0: s = sn; c = cs; break; case 1: s = cs; c = -sn; break; case 2: s = -sn; c = -cs; break; default: s = -cs; c = sn; break; }
}

#ifndef QR_A
#define QR_A 8
#endif
#ifndef QR_M
#define QR_M 0
#endif
struct Args { const float* in[16]; float* out; unsigned char* ws; int ph_lo, ph_hi; };
constexpr int N_PHASES = 2 + 8 * DEPTH;

template <bool QKPERM>
__device__ __forceinline__ void p0_transpose_item(const float* W, int K, int N, bf16* WT, LAS float* scr, int item, int lane) {
    const int nblk = N / 32, kb = item / nblk, nb = item % nblk, k0 = 64 * kb, n0 = 32 * nb;
#pragma unroll 8
    for (int i = 0; i < 32; ++i) { const int kk = 2 * i + (lane >> 5); scr[kk * 33 + (lane & 31)] = __builtin_nontemporal_load(W + (size_t)(k0 + kk) * N + n0 + (lane & 31)); }
    asm volatile("s_waitcnt lgkmcnt(0)" ::: "memory");
    const int c = lane & 7;
#pragma unroll
    for (int j = 0; j < 4; ++j) { const int n = (lane >> 3) + 8 * j; const LAS float* s = scr + (8 * c) * 33 + n;
        u32x4 o; o.x = pk2(s[0 * 33], s[1 * 33]); o.y = pk2(s[2 * 33], s[3 * 33]); o.z = pk2(s[4 * 33], s[5 * 33]); o.w = pk2(s[6 * 33], s[7 * 33]);
        int nr = n0 + n;
        if (QKPERM) { const int slot = nr >> 7, e = nr & 127; const bool isv = (slot == 6 || slot == 7 || (slot >= 20 && slot < 26) || slot >= 34);
            if (!isv) nr = (slot << 7) | (e & 64) | (((e >> 2) & 7) << 3) | (((e >> 5) & 1) << 2) | (e & 3); }
        *(u32x4*)(WT + (size_t)nr * K + k0 + 8 * c) = o; }
    asm volatile("s_waitcnt lgkmcnt(0)" ::: "memory");
}

template <class T> __device__ __forceinline__ T* as_global(T* p) { GAS T* g = (GAS T*)p; asm volatile("" : "+s"(g)); return (T*)g; }
#define PHASE_BEGIN() \
    int tid; asm volatile("v_mbcnt_lo_u32_b32 %0, -1, 0\n\tv_mbcnt_hi_u32_b32 %0, -1, %0" : "=v"(tid)); tid += wave0 * 64; \
    const CAS Args* ap = (const CAS Args*)__builtin_amdgcn_kernarg_segment_ptr(); asm volatile("" : "+s"(ap)); \
    int G = gridDim.x, bx = blockIdx.x; asm volatile("" : "+s"(G), "+s"(bx)); \
    const int lane = tid & 63, wave = __builtin_amdgcn_readfirstlane(tid >> 6); \
    const int vcu = (G % 8 == 0) ? (bx % 8) * (G / 8) + bx / 8 : bx; const int gw = vcu * 8 + wave, NGW = G * 8; \
    unsigned char* const ws = as_global(ap->ws); \
    (void)lane; (void)gw; (void)NGW; (void)ws
#define P_IN(k) (as_global(ap->in[k]))
#define P_XS (as_global(ap->out))
#define P_CS ((float*)(ws + WS_CS))
#define P_MOD ((float*)(ws + WS_MOD))
#define P_MODP ((float*)(ws + WS_MODP))
#define P_ROPE ((float2*)(ws + WS_ROPE))
#define P_GV ((float*)(ws + WS_GV))
#define P_HB ((bf16*)(ws + WS_H))
#define P_QKV ((bf16*)(ws + WS_QKV))
#define P_YB ((bf16*)(ws + WS_Y))
#define P_HID ((bf16*)(ws + WS_HID))
#define P_SLAB ((float*)(ws + WS_SLAB))

__global__ void __launch_bounds__(512, 2) trunk_fwd(Args args) {
    extern __shared__ __attribute__((aligned(16))) unsigned char lds[];
    LAS unsigned char* ldsl = (LAS unsigned char*)lds;
    volatile LAS unsigned* MISC = (volatile LAS unsigned*)(ldsl + MISC_OFF);
    for (int u = threadIdx.x; u < (LDS_BYTES - MISC_OFF) / 4; u += 512) ((LAS unsigned*)(ldsl + MISC_OFF))[u] = 0u;
    const int wave0 = __builtin_amdgcn_readfirstlane((int)threadIdx.x >> 6);
    __syncthreads();
    const int lo = args.ph_lo, hi = args.ph_hi;
    unsigned* const barw = (unsigned*)(args.ws + WS_CTL) + CW_BAR;
    XcdBarrier bar; bar.bar = barw; bar.x = 0; bar.st = nullptr;
    if (hi - lo > 1) bar = xcd_barrier_post(barw, MISC + 8);
#define IN(k) (lo <= (k) && (k) < hi)
#define SEAM(k) do { if ((k) + 1 < hi) xcd_barrier(bar); } while (0)

    if (IN(0)) {
        PHASE_BEGIN();
        const float* c_in = P_IN(1); const float* cctx_in = P_IN(3); const float* w_mod = P_IN(4);
        LAS float* cond = (LAS float*)(ldsl + 8 * 8448);
        for (int i = tid; i < 3 * DM; i += 512) { const float v = (i < 2 * DM) ? c_in[i] : cctx_in[i - 2 * DM]; cond[i] = v / (1.0f + expf(-v)); }
        __syncthreads();
        float* modp = P_MODP;
        for (int it = gw; it < DEPTH * 48 * 8; it += NGW) {
            const int l = it / 384, r = it % 384, nb = r >> 3, kc = r & 7, k0 = kc * 256, n0 = nb * 256 + 4 * lane;
            const float* W = w_mod + ((size_t)l * DM + k0) * MODW + n0;
            f32x4 a0 = {0.f, 0.f, 0.f, 0.f}, a1 = a0, a2 = a0;
#pragma unroll 8
            for (int kk = 0; kk < 256; ++kk) { const f32x4 w = __builtin_nontemporal_load((const f32x4*)(W + (size_t)kk * MODW));
                a0 += cond[k0 + kk] * w; a1 += cond[DM + k0 + kk] * w; a2 += cond[2 * DM + k0 + kk] * w; }
            float* P = modp + ((size_t)(l * 8 + kc) * 3) * MODW + n0;
            *(f32x4*)(P) = a0; *(f32x4*)(P + MODW) = a1; *(f32x4*)(P + 2 * MODW) = a2;
        }
        if (bx == 0) { float2* ropet = P_ROPE; for (int i = tid; i < 128 * 32; i += 512) { const int pos = i >> 5, f = i & 31; const float ang = (float)pos * ROPE_INV[f]; double sn, cn; sincos_d((double)ang, sn, cn); ropet[i] = make_float2((float)cn, (float)sn); } }
        LAS float* scr = (LAS float*)(ldsl + wave * 8448);
        constexpr int I_IN = (DM / 64) * (DIN / 32), I_OUT = (DM / 64) * (DM / 32), I_UP = (DM / 64) * (DFF / 32), I_DOWN = (DFF / 64) * (DM / 32);
        constexpr int I_LAYER = I_IN + I_OUT + I_UP + I_DOWN;
        for (int it = gw; it < DEPTH * I_LAYER; it += NGW) {
            const int l = it / I_LAYER; int r = it % I_LAYER;
            unsigned char* wl = ws + WS_W + (size_t)l * W_LAYER_B;
            if (r < I_IN) { p0_transpose_item<true>(P_IN(8) + (size_t)l * DM * DIN, DM, DIN, (bf16*)wl, scr, r, lane); continue; } r -= I_IN;
            if (r < I_OUT) { p0_transpose_item<false>(P_IN(13) + (size_t)l * DM * DM, DM, DM, (bf16*)(wl + W_IN_B), scr, r, lane); continue; } r -= I_OUT;
            if (r < I_UP) { p0_transpose_item<false>(P_IN(14) + (size_t)l * DM * DFF, DM, DFF, (bf16*)(wl + W_IN_B + W_OUT_B), scr, r, lane); continue; } r -= I_UP;
            p0_transpose_item<false>(P_IN(15) + (size_t)l * DFF * DM, DFF, DM, (bf16*)(wl + W_IN_B + W_OUT_B + W_UP_B), scr, r, lane);
        }
        SEAM(0);
    }
    if (IN(1)) {
        PHASE_BEGIN();
        const float* b_mod = P_IN(5); const float* modp = P_MODP; float* modv = P_MOD; const float* nrm_a = P_IN(6); const float* nrm_m = P_IN(7); float* gvw = P_GV;
        for (int i = (vcu * 512 + tid) * 4; i < DEPTH * 3 * MODW; i += G * 512 * 4) {
            const int l = i / (3 * MODW), r = i % (3 * MODW), v = r / MODW, n = r % MODW;
            f32x4 s = *(const f32x4*)(b_mod + (size_t)l * MODW + n);
#pragma unroll
            for (int kc = 0; kc < 8; ++kc) s += *(const f32x4*)(modp + ((size_t)(l * 8 + kc) * 3 + v) * MODW + n);
            *(f32x4*)(modv + i) = s;
            const int part = n / DM;
            if (part == 1 || part == 4) { const int wh = part == 4, c = n - part * DM; const f32x4 g = *(const f32x4*)((wh ? nrm_m : nrm_a) + (size_t)l * DM + c);
                *(f32x4*)(gvw + (((size_t)l * 2 + wh) * 3 + v) * DM + c) = g * (1.0f + s); }
        }
        SEAM(1);
    }

#define NORM_FINISH(m, xv, ss, V) do { const float rstd = 1.0f / sqrtf((ss) * (1.0f / DM) + EPS); \
        const float* gvp = gvl + (size_t)(V) * DM; const float* shp = modl + (size_t)(V) * MODW + (which_) * 3 * DM; bf16* orow = Hb + (size_t)(m) * DM; \
        _Pragma("unroll") for (int j = 0; j < 8; ++j) { const int cidx = 4 * lane + 256 * j; const f32x4 gq = *(const f32x4*)(gvp + cidx), shq = *(const f32x4*)(shp + cidx); \
            const f32x4 h = (xv[j] * rstd) * gq + shq; u32x2 w; w.x = pk2(h[0], h[1]); w.y = pk2(h[2], h[3]); *(u32x2*)(orow + cidx) = w; } } while (0)
#define NORM_CTX_ROWS(NSLAB, CRES, GATE) do { \
        LAS float* red = (LAS float*)ldsl; float* csw = P_CS; const float* slab = P_SLAB; \
        const float* gvp = gvl + (size_t)2 * DM; const float* shp = modl + (size_t)2 * MODW + which_ * 3 * DM; \
        f32x4 xr[2]; float ssr[2]; const int cc = 256 * wave + 4 * lane; \
        _Pragma("unroll") for (int rr = 0; rr < 2; ++rr) { const int r = 2 * vcu + rr; ssr[rr] = 0.f; xr[rr] = (f32x4){0.f, 0.f, 0.f, 0.f}; \
            if (r < 2 * CTX) { f32x4 x = *(const f32x4*)((CRES) + (size_t)r * DM + cc); \
                if ((NSLAB) > 0) { f32x4 a = {0.f, 0.f, 0.f, 0.f}; for (int sp = 0; sp < (NSLAB); ++sp) a += *(const f32x4*)(slab + ((size_t)sp * 512 + r) * DM + cc); \
                    x += *(const f32x4*)((GATE) + cc) * a; *(f32x4*)(csw + (size_t)r * DM + cc) = x; } \
                xr[rr] = x; ssr[rr] = (x[0] * x[0] + x[1] * x[1]) + (x[2] * x[2] + x[3] * x[3]); } } \
        wave_sum2(ssr[0], ssr[1]); \
        if (lane == 0) { red[wave] = ssr[0]; red[8 + wave] = ssr[1]; } \
        __syncthreads(); \
        _Pragma("unroll") for (int rr = 0; rr < 2; ++rr) { const int r = 2 * vcu + rr; \
            if (r < 2 * CTX) { float tot = 0.f; _Pragma("unroll") for (int w8 = 0; w8 < 8; ++w8) tot += red[rr * 8 + w8]; \
                const float rstd = 1.0f / sqrtf(tot * (1.0f / DM) + EPS); const f32x4 gq = *(const f32x4*)(gvp + cc), shq = *(const f32x4*)(shp + cc); \
                const f32x4 h = (xr[rr] * rstd) * gq + shq; u32x2 w; w.x = pk2(h[0], h[1]); w.y = pk2(h[2], h[3]); \
                *(u32x2*)(Hb + ((size_t)(r >> 8) * TPB + (r & 255)) * DM + cc) = w; } } \
        __syncthreads(); } while (0)
#define NORM_SETUP(which) const int which_ = (which); const float* __restrict__ modl = P_MOD + (size_t)l * 3 * MODW; const float* __restrict__ gvl = P_GV + ((size_t)l * 2 + which_) * 3 * DM; bf16* __restrict__ Hb = P_HB
#define NORM_PHASE(FIRST) do { \
        const float* __restrict__ src_lat = (FIRST) ? P_IN(0) : (const float*)P_XS; \
        for (int r0 = gw; r0 < NB * SEQ; r0 += 4 * NGW) { \
            int rq[4]; bool hq[4]; f32x4 xq[4][8]; float sq[4]; \
            _Pragma("unroll") for (int q = 0; q < 4; ++q) { const int rr_ = r0 + q * NGW; hq[q] = rr_ < NB * SEQ; rq[q] = hq[q] ? rr_ : r0; } \
            _Pragma("unroll") for (int q = 0; q < 4; ++q) { const float* sp_ = src_lat + (size_t)rq[q] * DM + 4 * lane; \
                _Pragma("unroll") for (int j = 0; j < 8; ++j) xq[q][j] = __builtin_nontemporal_load((const f32x4*)(sp_ + 256 * j)); } \
            _Pragma("unroll") for (int q = 0; q < 4; ++q) { float a_ = 0.f; \
                _Pragma("unroll") for (int j = 0; j < 8; ++j) a_ += (xq[q][j][0] * xq[q][j][0] + xq[q][j][1] * xq[q][j][1]) + (xq[q][j][2] * xq[q][j][2] + xq[q][j][3] * xq[q][j][3]); sq[q] = a_; } \
            wave_sum2(sq[0], sq[1]); wave_sum2(sq[2], sq[3]); \
            _Pragma("unroll") for (int q = 0; q < 4; ++q) if (hq[q]) { const int v_ = rq[q] >> 13; NORM_FINISH(v_ * TPB + CTX + (rq[q] & (SEQ - 1)), xq[q], sq[q], v_); } \
        } } while (0)

    for (int l = 0; l < DEPTH; ++l) {
        const int pb = 2 + 8 * l; const bool lastl = (l == DEPTH - 1);

        if (IN(pb + 0)) { PHASE_BEGIN(); NORM_SETUP(0); NORM_PHASE(l == 0);
            if (l == 0) NORM_CTX_ROWS(0, P_IN(2), P_IN(2)); else NORM_CTX_ROWS(16, (const float*)P_CS, P_MOD + ((size_t)(l - 1) * 3 + 2) * MODW + 5 * DM);
            SEAM(pb + 0); }

        if (IN(pb + 1)) {
            PHASE_BEGIN();
            pg8::Gemm g{P_HB, (const bf16*)(ws + WS_W + (size_t)l * W_LAYER_B), MT, DIN, DM, DM}; pg8::TileOrder S; S.init(66, DIN / 256, G, bx, 0, DM);
            pg8::EpiQKV E{P_QKV, P_IN(9) + (size_t)l * 384, P_IN(10) + (size_t)l * 384, (const float*)P_ROPE, (LAS float*)(ldsl + RING_BYTES)};
            pg8::gemm_phase<pg8::EpiQKV, pg8::TileOrder, true, true>(ldsl, g, S, E, tid);
            SEAM(pb + 1);
        }


        if (IN(pb + 3)) {
            PHASE_BEGIN();
            char* alds = (char*)lds; const bf16* QKV = P_QKV; bf16* Yb = P_YB; const float* sinks = P_IN(12);
#define QH(col, row) (QKV + ((size_t)((col) >> 7) * MT + (row)) * 128)
            for (int k = 0; k < 2; ++k) {
                int q_row0 = 0, qcol = 0, kcol = 0, vcol = 0, ycol = 0, bb = 0, NT = 4; float sink = -1e30f; bool run = false;
                if (k == 0) { if (vcu < 256) { const int i = vcu; run = true; bb = i >> 7; const int hq = (i >> 5) & 3, qb = i & 31; q_row0 = bb * TPB + CTX + qb * 256; qcol = hq * 128; kcol = 512 + (hq >> 1) * 128; vcol = 768 + (hq >> 1) * 128; ycol = hq * 128; NT = 132; } }
                else if (!lastl) { const int i = (vcu + G - G / 2) % G; if (i < 32) { run = true; bb = i >> 4; const int h16 = i & 15; q_row0 = bb * TPB; ycol = h16 * 128; NT = 4;
                        if (h16 < 4) { qcol = h16 * 128; kcol = 512 + (h16 >> 1) * 128; vcol = 768 + (h16 >> 1) * 128; }
                        else if (h16 < 10) { const int h = h16 - 4; qcol = 1024 + h * 128; kcol = 1792 + h * 128; vcol = 2560 + h * 128; }
                        else { const int h = h16 - 10; qcol = 3328 + h * 128; kcol = 4096 + (h / 3) * 128; vcol = 4352 + (h / 3) * 128; sink = sinks[l * 6 + h] * 1.4426950408889634f; } } }
                if (run) att::attn_unit<0, QR_A, 3>(QH(qcol, q_row0), QH(kcol, bb * TPB), QH(vcol, bb * TPB), Yb + (size_t)q_row0 * DM + ycol, NT, NT, 0, 0, sink, alds, tid);
            }
#define FRESH_TID(name) int name; asm volatile("v_mbcnt_lo_u32_b32 %0, -1, 0\n\tv_mbcnt_hi_u32_b32 %0, -1, %0" : "=v"(name)); name += wave0 * 64
            FRESH_TID(tidb);
            for (int i = vcu; i < 384; i += G) {
                const int bb = i / 192, rem = i % 192, h = rem >> 5, qb = rem & 31, r0 = qb * 4;
                const int rlo = min(max(r0 - 4, 0), 120), rhi = min(max(r0 + 3 - 4, 0), 120) + 7, NTR = 4 + (rhi - rlo + 1), NT = (NTR + 1) & ~1;
                const int q_row0 = bb * TPB + CTX + qb * 256;
                { float* rp = (float*)(alds + att::OFF_RPB); const float* src = P_IN(11) + ((size_t)l * 6 + h) * 465; for (int e = tidb; e < 465; e += 512) rp[e] = src[e] * (1.0f / att::SCALE); }
                att::attn_unit<2, QR_M, 2>(QH(1024 + h * 128, q_row0), QH(1792 + h * 128, bb * TPB), QH(2560 + h * 128, bb * TPB), Yb + (size_t)q_row0 * DM + 512 + h * 128, NT, NTR, rlo, qb * 256, -1e30f, alds, tidb);
            }
            FRESH_TID(tidc);
            for (int i = G - 1 - vcu; i < 384; i += G) {
                const int bb = i / 192, rem = i % 192, h = rem >> 5, qb = rem & 31, q0 = qb * 256;
                const int tlo = max(q0 - 128, 0) >> 6, thi = min(q0 + 384, SEQ) >> 6, NTR = 4 + (thi - tlo), NT = (NTR + 1) & ~1;
                const int q_row0 = bb * TPB + CTX + q0;
                att::attn_unit<1, QR_M, 2>(QH(3328 + h * 128, q_row0), QH(4096 + (h / 3) * 128, bb * TPB), QH(4352 + (h / 3) * 128, bb * TPB), Yb + (size_t)q_row0 * DM + 1280 + h * 128, NT, NTR, tlo, q0, sinks[l * 6 + h] * 1.4426950408889634f, alds, tidc);
            }
            SEAM(pb + 3);
        }

        if (IN(pb + 4)) {
            PHASE_BEGIN();
            pg8::Gemm g{P_YB, (const bf16*)(ws + WS_W + (size_t)l * W_LAYER_B + W_IN_B), MT, DM, DM, DM}; pg8::TileOrder S; S.init(64, DM / 256, G, bx, 1, DM); if (!lastl) S.add_ctx_split(8);
            pg8::EpiRes E{(l == 0) ? P_IN(0) : (const float*)P_XS, (l == 0) ? P_IN(2) : (const float*)P_CS, P_XS, P_CS, P_MOD + (size_t)l * 3 * MODW + 2 * DM, P_SLAB};
            pg8::gemm_phase<pg8::EpiRes, pg8::TileOrder, true, true>(ldsl, g, S, E, tid);
            SEAM(pb + 4);
        }
        if (IN(pb + 5)) { PHASE_BEGIN(); NORM_SETUP(1); NORM_PHASE(false);
            if (!lastl) { if (l == 0) NORM_CTX_ROWS(8, P_IN(2), P_MOD + ((size_t)l * 3 + 2) * MODW + 2 * DM); else NORM_CTX_ROWS(8, (const float*)P_CS, P_MOD + ((size_t)l * 3 + 2) * MODW + 2 * DM); }
            SEAM(pb + 5); }

        if (IN(pb + 6)) {
            PHASE_BEGIN();
            pg8::Gemm g{P_HB, (const bf16*)(ws + WS_W + (size_t)l * W_LAYER_B + W_IN_B + W_OUT_B), MT, DFF, DM, DM}; pg8::TileOrder S; S.init(lastl ? 64 : 66, DFF / 256, G, bx, lastl ? 1 : 0, DM);
            pg8::EpiBf16<3> E{P_HID, DFF};
            pg8::gemm_phase<pg8::EpiBf16<3>, pg8::TileOrder, true, true>(ldsl, g, S, E, tid);
            SEAM(pb + 6);
        }
        if (IN(pb + 7)) {
            PHASE_BEGIN();
            pg8::Gemm g{P_HID, (const bf16*)(ws + WS_W + (size_t)l * W_LAYER_B + W_IN_B + W_OUT_B + W_UP_B), MT, DM, DFF, DFF}; pg8::TileOrder S; S.init(64, DM / 256, G, bx, 1, DFF); if (!lastl) S.add_ctx_split(16);
            pg8::EpiRes E{P_XS, P_CS, P_XS, P_CS, P_MOD + (size_t)l * 3 * MODW + 5 * DM, P_SLAB};
            pg8::gemm_phase<pg8::EpiRes, pg8::TileOrder, true, true>(ldsl, g, S, E, tid);
            SEAM(pb + 7);
        }
    }
#undef IN
#undef SEAM
}

extern "C" void kernel_launch(void* const* d_in, const int* in_sizes, int n_in, void* d_out, int out_size, void* d_ws, size_t ws_size, hipStream_t stream) {
    static int grid = 0;
    if (grid == 0) {
        if (n_in != 16 || in_sizes[0] != NB * SEQ * DM || out_size != NB * SEQ * DM || ws_size < WS_END) {
            fprintf(stderr, "kernel_launch: shape mismatch: n_in %d in0 %d out %d ws %zu (need %zu)\n", n_in, n_in > 0 ? in_sizes[0] : -1, out_size, ws_size, (size_t)WS_END); grid = -1; return; }
        int dev = 0, cus = 0, per_cu = 0;
        if (hipGetDevice(&dev) != hipSuccess || hipDeviceGetAttribute(&cus, hipDeviceAttributeMultiprocessorCount, dev) != hipSuccess) { fprintf(stderr, "kernel_launch: device query failed\n"); grid = -1; return; }
        if (hipFuncSetAttribute((const void*)trunk_fwd, hipFuncAttributeMaxDynamicSharedMemorySize, LDS_BYTES) != hipSuccess) { fprintf(stderr, "kernel_launch: hipFuncSetAttribute failed\n"); grid = -1; return; }
        if (hipOccupancyMaxActiveBlocksPerMultiprocessor(&per_cu, (const void*)trunk_fwd, 512, LDS_BYTES) != hipSuccess || per_cu < 1)
            fprintf(stderr, "kernel_launch: note: occupancy query reports %d workgroups per CU\n", per_cu);
        (void)hipGetLastError();
        grid = cus;
    }
    if (grid < 0) return;
    if (hipMemsetAsync((char*)d_ws + WS_CTL, 0, CTL_ZERO_BYTES, stream) != hipSuccess) { fprintf(stderr, "kernel_launch: memset failed\n"); return; }
    Args a{};
    for (int i = 0; i < 16; ++i) a.in[i] = (const float*)d_in[i];
    a.out = (float*)d_out; a.ws = (unsigned char*)d_ws;
#if MK_PER_PHASE_LAUNCH
    for (int p = 0; p < N_PHASES; ++p) {
        a.ph_lo = p; a.ph_hi = p + 1;
        hipLaunchKernelGGL(trunk_fwd, dim3(grid), dim3(512), LDS_BYTES, stream, a);
    }
#else
    a.ph_lo = 0; a.ph_hi = N_PHASES;
    hipLaunchKernelGGL(trunk_fwd, dim3(grid), dim3(512), LDS_BYTES, stream, a);
#endif
    const hipError_t le = hipPeekAtLastError();
    if (le != hipSuccess) fprintf(stderr, "kernel_launch: launch failed: %s\n", hipGetErrorName(le));
}
```

```cpp
#include <hip/hip_runtime.h>
#include <cstdio>
#include <cstdint>

#ifndef MK_PER_PHASE_LAUNCH
#define MK_PER_PHASE_LAUNCH 0
#endif

constexpr int DM = 2048, NB = 2, SEQ = 8192, DEPTH = 4, CTX = 256, DIN = 4608, DFF = 8192;
constexpr int TPB = CTX + SEQ;
constexpr int MT = NB * TPB;
constexpr int MODW = 6 * DM;
constexpr float EPS = 1e-6f;

#define GAS __attribute__((address_space(1)))
#define LAS __attribute__((address_space(3)))
#define CAS __attribute__((address_space(4)))
typedef unsigned short bf16;
typedef float f32x4 __attribute__((ext_vector_type(4)));
typedef unsigned u32x4 __attribute__((ext_vector_type(4)));
typedef unsigned u32x2 __attribute__((ext_vector_type(2)));

__device__ __forceinline__ unsigned f2bf(float f) { unsigned u = __builtin_bit_cast(unsigned, f); return (u + 0x7fffu + ((u >> 16) & 1u)) >> 16; }
__device__ __forceinline__ unsigned pk2(float lo, float hi) { return f2bf(lo) | (f2bf(hi) << 16); }
__device__ __forceinline__ float bf2f(unsigned b) { return __builtin_bit_cast(float, b << 16); }
#define SWZ_XOR(v, x) __builtin_bit_cast(float, __builtin_amdgcn_ds_swizzle(__builtin_bit_cast(int, (v)), 0x1F | ((x) << 10)))
__device__ __forceinline__ float lane_xor16(float v) { return SWZ_XOR(v, 16); }
__device__ __forceinline__ void wave_sum2(float& v, float& w) {
    v += SWZ_XOR(v, 1); w += SWZ_XOR(w, 1); v += SWZ_XOR(v, 2); w += SWZ_XOR(w, 2); v += SWZ_XOR(v, 4); w += SWZ_XOR(w, 4); v += SWZ_XOR(v, 8); w += SWZ_XOR(w, 8); v += SWZ_XOR(v, 16); w += SWZ_XOR(w, 16);
    float a = v, b = v, c = w, d = w; asm volatile("s_nop 1\n\tv_permlane32_swap_b32 %0, %1\n\tv_permlane32_swap_b32 %2, %3\n\ts_nop 1" : "+v"(a), "+v"(b), "+v"(c), "+v"(d));
    v = a + b; w = c + d;
}
__device__ __forceinline__ float wave_sum(float v) {
    v += SWZ_XOR(v, 1); v += SWZ_XOR(v, 2); v += SWZ_XOR(v, 4); v += SWZ_XOR(v, 8); v += SWZ_XOR(v, 16);
    float a = v, b = v; asm volatile("s_nop 1\n\tv_permlane32_swap_b32 %0, %1\n\ts_nop 1" : "+v"(a), "+v"(b));
    return a + b;
}

namespace pg8 {
#define PG8_LAS __attribute__((address_space(3)))
typedef unsigned short bf16_t;
typedef short bf16x8 __attribute__((ext_vector_type(8)));
typedef float f32x4 __attribute__((ext_vector_type(4)));
typedef unsigned u32x4 __attribute__((ext_vector_type(4)));
constexpr int BM = 256, BK = 64, HALF = 128, HTB = HALF * BK * 2, STAGE_BYTES = 8 * HTB, NXCD = 8, WGM = 4;

__host__ __device__ __forceinline__ int lds_byte(int r, int c) { const int st = (r >> 4) * 2 + (c >> 5), rr = r & 15, cc = c & 31, ob = rr * 64 + cc * 2; return st * 1024 + (ob ^ (((ob >> 9) & 1) << 5)); }
__host__ __device__ __forceinline__ void stage_rc(int b, int& R, int& C) { const int st = b / 1024, sb = b % 1024, swz = sb ^ (((sb >> 9) & 1) << 5); R = (st >> 1) * 16 + swz / 64; C = (st & 1) * 32 + (swz % 64) / 2; }
__host__ __device__ __forceinline__ int perm32(int rho) { const int n = rho >> 4, i = rho & 15; return 8 * (i >> 2) + 4 * n + (i & 3); }

struct Unit { int pm, pn, k0, nt, ks; };
struct Gemm { const bf16_t* A; const bf16_t* Bt; int M, N, K, ld; };

struct TileOrder {
    int nM, nN, nwg, G, c, skip, ntk, nsub, S, ntsub, stag;
    __device__ void init(int nM_, int nN_, int G_, int c_, int skip_, int K_) { nM = nM_; nN = nN_; nwg = nM * nN; G = G_; c = c_; skip = skip_; ntk = K_ / BK; nsub = 0; S = 1; ntsub = 0; stag = 0; }
    __device__ void add_ctx_split(int S_) { S = S_; ntsub = ntk / S_; nsub = 2 * nN * S_; stag = (nsub == G) ? 1 : (2 * nsub == G) ? 2 : 0; }
    __device__ void sub_unit(int q, Unit& u) const { u.ks = q % S; const int r = q / S; u.pn = r % nN; u.pm = (r / nN) * 33; u.k0 = u.ks * ntsub * BK; u.nt = ntsub; }
    __device__ bool next(int i, Unit& u) const {
        int ii = i;
        if (stag && (c & 1)) { if (i == 0) { sub_unit(stag == 1 ? c : (c >> 1), u); return true; } ii = i - 1; }
        const long L = (long)ii * G + c;
        if (L >= nwg) { if (stag == 2 || (stag == 1 && (c & 1))) return false; const int q = (int)(L - nwg); if (q >= nsub) return false; sub_unit(q, u); return true; }
        u.k0 = 0; u.nt = ntk; u.ks = -1;
        int wgid = (int)L; { const int q = nwg / NXCD, r = nwg % NXCD, xcd = wgid % NXCD, off = wgid / NXCD; wgid = (xcd < r ? xcd * (q + 1) : r * (q + 1) + (xcd - r) * q) + off; }
        const int nig = WGM * nN, gid = wgid / nig, fm = gid * WGM, gsz = (nM - fm) < WGM ? (nM - fm) : WGM;
        int pm = fm + ((wgid % nig) % gsz); u.pn = (wgid % nig) / gsz;
        if (skip) pm = pm + 1 + (pm >= 32 ? 1 : 0);
        u.pm = pm; return true;
    }
    __device__ __forceinline__ void a_ready(const Unit&) const {}
    __device__ __forceinline__ void done(const Unit&) const {}
};

__device__ __forceinline__ unsigned cvt_pk_bf16(float lo, float hi) { unsigned r; asm volatile("v_cvt_pk_bf16_f32 %0, %1, %2" : "=v"(r) : "v"(lo), "v"(hi)); return r; }

template <int ACT  > struct EpiBf16 {
    static constexpr bool PERM = true, AFTER_DRAIN = false;
    bf16_t* O; int ldc;
    __device__ __forceinline__ void operator()(const f32x4 (&acc)[2][2][4][2], const Unit& u, int wr, int wc, int fr, int fq) const {
        asm volatile("" : "+v"(fr), "+v"(fq));
        const int row0 = u.pm * BM + wr * 64 + fr; const int col0 = u.pn * BM + wc * 32 + 8 * fq;
#pragma unroll
        for (int ai = 0; ai < 2; ++ai)
#pragma unroll
            for (int m = 0; m < 4; ++m) { bf16_t* rowp = O + (size_t)(row0 + ai * HALF + m * 16) * ldc + col0;
#pragma unroll
                for (int bj = 0; bj < 2; ++bj) { f32x4 v0 = acc[ai][bj][m][0], v1 = acc[ai][bj][m][1];
                    if (ACT == 3) {
#pragma unroll
                        for (int j = 0; j < 4; ++j) { const float a = fmaxf(v0[j], 0.f), b = fmaxf(v1[j], 0.f); v0[j] = a * a; v1[j] = b * b; } }
                    u32x4 w; w.x = cvt_pk_bf16(v0[0], v0[1]); w.y = cvt_pk_bf16(v0[2], v0[3]); w.z = cvt_pk_bf16(v1[0], v1[1]); w.w = cvt_pk_bf16(v1[2], v1[3]);
                    *(u32x4*)(rowp + bj * HALF) = w; } }
    }
};
struct EpiQKV {
    static constexpr bool PERM = true, AFTER_DRAIN = false;
    bf16_t* O; const float* qn; const float* kn; const float* rope; PG8_LAS float* P;
    __device__ __forceinline__ void operator()(const f32x4 (&acc)[2][2][4][2], const Unit& u, int wr, int wc, int fr, int fq) const {
        asm volatile("" : "+v"(fr), "+v"(fq));
        const int pn = u.pn;
        const int typ = (pn < 2) ? 0 : (pn == 2) ? 1 : (pn == 3) ? 2 : (pn < 7) ? 0 : (pn < 10) ? 1 : (pn < 13) ? 2 : (pn < 16) ? 0 : (pn == 16) ? 1 : 2;
        const int grp = (pn < 4) ? 0 : (pn < 13) ? 1 : 2;
        const int row0 = u.pm * BM + wr * 64 + fr, col0 = wc * 32 + 8 * fq;
        bf16_t* const Oh = O + ((size_t)(2 * pn) * 16896) * 128; constexpr size_t HSTR = (size_t)16896 * 128;
        if (typ == 2) {
#pragma unroll
            for (int ai = 0; ai < 2; ++ai)
#pragma unroll
                for (int m = 0; m < 4; ++m) { bf16_t* rowp = Oh + (size_t)(row0 + ai * HALF + m * 16) * 128 + col0;
#pragma unroll
                    for (int bj = 0; bj < 2; ++bj) { const f32x4 v0 = acc[ai][bj][m][0], v1 = acc[ai][bj][m][1];
                        u32x4 w; w.x = cvt_pk_bf16(v0[0], v0[1]); w.y = cvt_pk_bf16(v0[2], v0[3]); w.z = cvt_pk_bf16(v1[0], v1[1]); w.w = cvt_pk_bf16(v1[2], v1[3]);
                        *(u32x4*)(rowp + bj * HSTR) = w; } }
            return;
        }
#pragma unroll
        for (int ai = 0; ai < 2; ++ai)
#pragma unroll
            for (int m = 0; m < 4; ++m) { float s0, s1;
                { const f32x4 a = acc[ai][0][m][0], b = acc[ai][0][m][1]; s0 = ((a[0] * a[0] + a[1] * a[1]) + (a[2] * a[2] + a[3] * a[3])) + ((b[0] * b[0] + b[1] * b[1]) + (b[2] * b[2] + b[3] * b[3])); }
                { const f32x4 a = acc[ai][1][m][0], b = acc[ai][1][m][1]; s1 = ((a[0] * a[0] + a[1] * a[1]) + (a[2] * a[2] + a[3] * a[3])) + ((b[0] * b[0] + b[1] * b[1]) + (b[2] * b[2] + b[3] * b[3])); }
                s0 += SWZ_XOR(s0, 16); s1 += SWZ_XOR(s1, 16);
                float a0 = s0, b0 = s0, a1 = s1, b1 = s1; asm volatile("s_nop 1\n\tv_permlane32_swap_b32 %0, %1\n\tv_permlane32_swap_b32 %2, %3\n\ts_nop 1" : "+v"(a0), "+v"(b0), "+v"(a1), "+v"(b1));
                if (fq == 0) { PG8_LAS float* pr = P + (ai * HALF + wr * 64 + m * 16 + fr) * 8 + wc; pr[0] = a0 + b0; pr[4] = a1 + b1; } }
        asm volatile("s_waitcnt lgkmcnt(0)" ::: "memory"); __builtin_amdgcn_s_barrier(); asm volatile("" ::: "memory");
        const int half = wc >> 1, gg = (4 * wc + fq) & 7;
        const float* gnp = ((typ == 0) ? qn : kn) + grp * 128 + half * 64 + gg * 4;
        const f32x4 gA = *(const f32x4*)gnp, gB = *(const f32x4*)(gnp + 32);
        const int b = u.pm / 33, j = u.pm - b * 33;
        const bool roped = (j != 0) && (grp != 1);
        f32x4 tb[4][2];
#pragma unroll
        for (int m = 0; m < 4; ++m) { tb[m][0] = (f32x4){1.f, 0.f, 1.f, 0.f}; tb[m][1] = (f32x4){1.f, 0.f, 1.f, 0.f}; }
        if (roped && half == 1) {
#pragma unroll
            for (int m = 0; m < 4; ++m) { const float* tp = rope + ((16 * m + fr) * 32 + gg * 4) * 2; tb[m][0] = *(const f32x4*)tp; tb[m][1] = *(const f32x4*)(tp + 4); } }
#pragma unroll
        for (int ai = 0; ai < 2; ++ai) {
            if (roped && half == 0) {
                const float* tp = rope + ((4 * (j - 1) + 2 * ai + wr) * 32 + gg * 4) * 2; const f32x4 t0 = *(const f32x4*)tp, t1 = *(const f32x4*)(tp + 4);
#pragma unroll
                for (int m = 0; m < 4; ++m) { tb[m][0] = t0; tb[m][1] = t1; } }
#pragma unroll
            for (int m = 0; m < 4; ++m) { bf16_t* rowp = Oh + (size_t)(row0 + ai * HALF + m * 16) * 128 + col0;
                const PG8_LAS float* pr = P + (ai * HALF + wr * 64 + m * 16 + fr) * 8;
                const f32x4 cvec = {tb[m][0][0], tb[m][0][2], tb[m][1][0], tb[m][1][2]}, svec = {tb[m][0][1], tb[m][0][3], tb[m][1][1], tb[m][1][3]};
#pragma unroll
                for (int bj = 0; bj < 2; ++bj) { const f32x4 pp = *(const PG8_LAS f32x4*)(pr + bj * 4);
                    const float rstd = 1.0f / sqrtf(((pp[0] + pp[1]) + (pp[2] + pp[3])) * (1.0f / 128.0f) + 1e-6f);
                    const f32x4 x0 = acc[ai][bj][m][0] * rstd * gA, x1 = acc[ai][bj][m][1] * rstd * gB;
                    const f32x4 y0 = x0 * cvec - x1 * svec, y1 = x1 * cvec + x0 * svec;
                    u32x4 w; w.x = cvt_pk_bf16(y0[0], y0[1]); w.y = cvt_pk_bf16(y0[2], y0[3]); w.z = cvt_pk_bf16(y1[0], y1[1]); w.w = cvt_pk_bf16(y1[2], y1[3]);
                    *(u32x4*)(rowp + bj * HSTR) = w; } }
        }
    }
};
struct EpiRes {
    static constexpr bool PERM = false, AFTER_DRAIN = false;
    const float* res_lat; const float* res_ctx; float* out_lat; float* out_ctx; const float* gate; float* slab;
    __device__ __forceinline__ void operator()(const f32x4 (&acc)[2][2][4][2], const Unit& u, int wr, int wc, int fr, int fq) const {
        asm volatile("" : "+v"(fr), "+v"(fq));
        const int b = u.pm / 33, j = u.pm - b * 33;
        if (u.ks >= 0) {
            float* sb = slab + ((size_t)(u.ks * 512 + b * 256) * 2048 + u.pn * BM);
            const int row0 = wr * 64 + fr, col0 = wc * 32 + 4 * fq;
#pragma unroll
            for (int ai = 0; ai < 2; ++ai)
#pragma unroll
                for (int m = 0; m < 4; ++m) { const unsigned off = (unsigned)(((row0 + ai * HALF + m * 16) * 2048 + col0) * 4);
#pragma unroll
                    for (int bj = 0; bj < 2; ++bj)
#pragma unroll
                        for (int n = 0; n < 2; ++n) *(f32x4*)((char*)sb + off + (unsigned)((bj * HALF + n * 16) * 4)) = acc[ai][bj][m][n]; }
            return;
        }
        const float* rb; float* ob; const float* gp;
        if (j == 0) { const size_t off = (size_t)(b * 256) * 2048; rb = res_ctx + off; ob = out_ctx + off; gp = gate + 2 * 12288; }
        else { const size_t off = (size_t)(b * 8192 + (j - 1) * 256) * 2048; rb = res_lat + off; ob = out_lat + off; gp = gate + b * 12288; }
        const int row0 = wr * 64 + fr, col0 = wc * 32 + 4 * fq;
        rb += u.pn * BM; ob += u.pn * BM; gp += u.pn * BM;
        f32x4 gv[2][2];
#pragma unroll
        for (int bj = 0; bj < 2; ++bj)
#pragma unroll
            for (int n = 0; n < 2; ++n) gv[bj][n] = *(const f32x4*)((const char*)gp + (unsigned)((col0 + bj * HALF + n * 16) * 4));
#pragma unroll
        for (int ai = 0; ai < 2; ++ai) {
            f32x4 rr[4][2][2];
#pragma unroll
            for (int m = 0; m < 4; ++m) { const unsigned off = (unsigned)(((row0 + ai * HALF + m * 16) * 2048 + col0) * 4);
#pragma unroll
                for (int bj = 0; bj < 2; ++bj)
#pragma unroll
                    for (int n = 0; n < 2; ++n) rr[m][bj][n] = *(const f32x4*)((const char*)rb + off + (unsigned)((bj * HALF + n * 16) * 4)); }
#pragma unroll
            for (int m = 0; m < 4; ++m) { const unsigned off = (unsigned)(((row0 + ai * HALF + m * 16) * 2048 + col0) * 4);
#pragma unroll
                for (int bj = 0; bj < 2; ++bj)
#pragma unroll
                    for (int n = 0; n < 2; ++n) *(f32x4*)((char*)ob + off + (unsigned)((bj * HALF + n * 16) * 4)) = rr[m][bj][n] + gv[bj][n] * acc[ai][bj][m][n]; }
            asm volatile("" ::: "memory"); }
    }
};

template <class Epi, class Sched, bool ALIGN_EPI = false, bool SP2 = false>
__device__ __forceinline__ void gemm_phase(PG8_LAS unsigned char* lds, const Gemm g, const Sched& S, const Epi& E, const int tid) {
    const int wid = __builtin_amdgcn_readfirstlane(tid >> 6), lane = tid & 63, wr = wid >> 2, wc = wid & 3, fr = lane & 15, fq = lane >> 4;
    const int LD = g.ld;
    unsigned voffA[2], voffB[2];
#pragma unroll
    for (int i = 0; i < 2; ++i) { int R, C; stage_rc(tid * 16 + i * 8192, R, C); const int Rb = Epi::PERM ? ((R & ~31) + perm32(R & 31)) : R;
        voffA[i] = (unsigned)(R * LD + C) * 2u; voffB[i] = (unsigned)(Rb * LD + C) * 2u; }
    const size_t kstep = (size_t)(BK * 2);
    const size_t hstep = (size_t)HALF * LD * 2;
    const size_t tstep = 2 * hstep;
    const unsigned ldsw = (unsigned)wid * 1024u;
    const int aoff = lds_byte(wr * 64 + fr, fq * 8), boff = lds_byte(wc * 32 + fr, fq * 8);
#define PG8_SA(b, h) (((b) * 2 + (h)) * HTB)
#define PG8_SB(b, h) ((4 + (b) * 2 + (h)) * HTB)
#define PG8_STAGE(bufoff, gbase, voff) do { _Pragma("unroll") for (int _i = 0; _i < 2; ++_i) \
        __builtin_amdgcn_global_load_lds((const unsigned*)((const char*)(gbase) + (voff)[_i]), (PG8_LAS unsigned*)(lds + (bufoff) + ldsw + _i * 8192), 16, 0, 0); } while (0)
#define PG8_LDA(dst, b, h) do { _Pragma("unroll") for (int m = 0; m < 4; ++m) _Pragma("unroll") for (int k = 0; k < 2; ++k) dst[m][k] = *(const PG8_LAS bf16x8*)(lds + PG8_SA(b, h) + aoff + m * 2048 + k * 1024); } while (0)
#define PG8_LDB(dst, b, h) do { _Pragma("unroll") for (int n = 0; n < 2; ++n) _Pragma("unroll") for (int k = 0; k < 2; ++k) dst[n][k] = *(const PG8_LAS bf16x8*)(lds + PG8_SB(b, h) + boff + n * 2048 + k * 1024); } while (0)
#define PG8_MMA(ai, bj, At, Bt) do { __builtin_amdgcn_s_setprio(1); _Pragma("unroll") for (int m = 0; m < 4; ++m) _Pragma("unroll") for (int n = 0; n < 2; ++n) _Pragma("unroll") for (int k = 0; k < 2; ++k) \
        acc[ai][bj][m][n] = __builtin_amdgcn_mfma_f32_16x16x32_bf16(Bt[n][k], At[m][k], acc[ai][bj][m][n], 0, 0, 0); __builtin_amdgcn_s_setprio(0); } while (0)
#define PG8_WAIT_V(n) asm volatile("s_waitcnt vmcnt(" #n ")" ::: "memory")
#define PG8_WAIT_L(n) asm volatile("s_waitcnt lgkmcnt(" #n ")" ::: "memory")
#define PG8_BAR __builtin_amdgcn_s_barrier()
#define PG8_SCHED __builtin_amdgcn_sched_barrier(0)
    Unit cur, nxt; int ui = 0;
    if (!S.next(0, cur)) return;
    f32x4 acc[2][2][4][2];
#pragma unroll
    for (int a = 0; a < 2; ++a)
#pragma unroll
        for (int b = 0; b < 2; ++b)
#pragma unroll
            for (int m = 0; m < 4; ++m)
#pragma unroll
                for (int n = 0; n < 2; ++n) acc[a][b][m][n] = (f32x4){0.f, 0.f, 0.f, 0.f};
    bf16x8 At[4][2], B0[2][2], B1[2][2];
    const char* cA = (const char*)g.A + (size_t)cur.pm * tstep + (size_t)cur.k0 * 2; const char* cB = (const char*)g.Bt + (size_t)cur.pn * tstep + (size_t)cur.k0 * 2;
    S.a_ready(cur);
    if constexpr (SP2) {
        PG8_STAGE(PG8_SB(0, 0), cB, voffB); PG8_STAGE(PG8_SB(0, 1), cB + hstep, voffB); PG8_STAGE(PG8_SA(0, 0), cA, voffA); PG8_STAGE(PG8_SA(0, 1), cA + hstep, voffA);
        if (wr == 1) PG8_BAR;
        PG8_WAIT_V(2); PG8_BAR;
        PG8_STAGE(PG8_SB(1, 0), cB + kstep, voffB); PG8_STAGE(PG8_SA(1, 0), cA + kstep, voffA); PG8_STAGE(PG8_SB(1, 1), cB + hstep + kstep, voffB);
        PG8_WAIT_V(6); PG8_BAR;
    } else {
        PG8_STAGE(PG8_SB(0, 0), cB, voffB); PG8_STAGE(PG8_SA(0, 0), cA, voffA); PG8_STAGE(PG8_SB(0, 1), cB + hstep, voffB); PG8_STAGE(PG8_SA(0, 1), cA + hstep, voffA);
        if (wr == 1) PG8_BAR;
        PG8_WAIT_V(4); PG8_BAR;
        PG8_STAGE(PG8_SB(1, 0), cB + kstep, voffB); PG8_STAGE(PG8_SA(1, 0), cA + kstep, voffA); PG8_STAGE(PG8_SB(1, 1), cB + hstep + kstep, voffB);
        PG8_WAIT_V(6); PG8_BAR;
    }
    for (;;) {
        const bool has_next = S.next(ui + 1, nxt);
        const char* nA = has_next ? (const char*)g.A + (size_t)nxt.pm * tstep + (size_t)nxt.k0 * 2 : cA; const char* nB = has_next ? (const char*)g.Bt + (size_t)nxt.pn * tstep + (size_t)nxt.k0 * 2 : cB;
        const int nt = cur.nt;
        for (int t = 0; t < nt; t += 2) {
            const bool last = (t == nt - 2);
            const char* a1 = cA + (size_t)(t + 1) * kstep;
            const char* a2 = last ? nA : cA + (size_t)(t + 2) * kstep; const char* b2 = last ? nB : cB + (size_t)(t + 2) * kstep;
            const char* a3 = a2 + kstep; const char* b3 = b2 + kstep;
            if (last && has_next) S.a_ready(nxt);
            if constexpr (SP2) {
            PG8_LDB(B0, 0, 0); PG8_LDB(B1, 0, 1); PG8_SCHED; PG8_LDA(At, 0, 0); PG8_STAGE(PG8_SA(1, 1), a1 + hstep, voffA);
            PG8_WAIT_V(8); PG8_WAIT_L(0); PG8_BAR; PG8_MMA(0, 0, At, B0); PG8_MMA(0, 1, At, B1); PG8_BAR; PG8_SCHED;
            PG8_LDA(At, 0, 1); PG8_STAGE(PG8_SB(0, 0), b2, voffB); PG8_STAGE(PG8_SB(0, 1), b2 + hstep, voffB); PG8_STAGE(PG8_SA(0, 0), a2, voffA);
            PG8_WAIT_V(8); PG8_WAIT_L(0); PG8_BAR; PG8_MMA(1, 0, At, B0); PG8_MMA(1, 1, At, B1); PG8_BAR; PG8_SCHED;
            PG8_LDB(B0, 1, 0); PG8_LDB(B1, 1, 1); PG8_SCHED; PG8_LDA(At, 1, 0); PG8_STAGE(PG8_SA(0, 1), a2 + hstep, voffA);
            PG8_WAIT_V(8); PG8_WAIT_L(0); PG8_BAR; PG8_MMA(0, 0, At, B0); PG8_MMA(0, 1, At, B1); PG8_BAR; PG8_SCHED;
            PG8_LDA(At, 1, 1); PG8_STAGE(PG8_SB(1, 0), b3, voffB); PG8_STAGE(PG8_SB(1, 1), b3 + hstep, voffB); PG8_STAGE(PG8_SA(1, 0), a3, voffA);
            PG8_WAIT_V(8); PG8_WAIT_L(0); PG8_BAR; PG8_MMA(1, 0, At, B0); PG8_MMA(1, 1, At, B1); PG8_BAR; PG8_SCHED;
            } else {
            PG8_LDB(B0, 0, 0); PG8_SCHED; PG8_LDA(At, 0, 0); PG8_STAGE(PG8_SA(1, 1), a1 + hstep, voffA);
            PG8_WAIT_L(8); PG8_BAR; PG8_WAIT_L(0); PG8_MMA(0, 0, At, B0); PG8_BAR; PG8_SCHED;
            PG8_LDB(B1, 0, 1); PG8_STAGE(PG8_SB(0, 0), b2, voffB);
            PG8_BAR; PG8_WAIT_L(0); PG8_MMA(0, 1, At, B1); PG8_BAR;
            PG8_LDA(At, 0, 1); PG8_STAGE(PG8_SA(0, 0), a2, voffA);
            PG8_BAR; PG8_WAIT_L(0); PG8_MMA(1, 0, At, B0); PG8_BAR; PG8_SCHED;
            PG8_STAGE(PG8_SB(0, 1), b2 + hstep, voffB);
            PG8_WAIT_V(6); PG8_BAR; PG8_MMA(1, 1, At, B1); PG8_BAR;
            PG8_LDB(B0, 1, 0); PG8_SCHED; PG8_LDA(At, 1, 0); PG8_STAGE(PG8_SA(0, 1), a2 + hstep, voffA);
            PG8_WAIT_L(8); PG8_BAR; PG8_WAIT_L(0); PG8_MMA(0, 0, At, B0); PG8_BAR; PG8_SCHED;
            PG8_LDB(B1, 1, 1); PG8_STAGE(PG8_SB(1, 0), b3, voffB);
            PG8_BAR; PG8_WAIT_L(0); PG8_MMA(0, 1, At, B1); PG8_BAR;
            PG8_LDA(At, 1, 1); PG8_STAGE(PG8_SA(1, 0), a3, voffA);
            PG8_BAR; PG8_WAIT_L(0); PG8_MMA(1, 0, At, B0); PG8_BAR; PG8_SCHED;
            PG8_STAGE(PG8_SB(1, 1), b3 + hstep, voffB);
            PG8_WAIT_V(6); PG8_BAR; PG8_MMA(1, 1, At, B1); PG8_BAR;
            }
        }
        if constexpr (ALIGN_EPI) { if (wr == 0) PG8_BAR; }
        if constexpr (!Epi::AFTER_DRAIN) { E(acc, cur, wr, wc, fr, fq); S.done(cur); }
        if (!has_next) break;
#pragma unroll
        for (int a = 0; a < 2; ++a)
#pragma unroll
            for (int b = 0; b < 2; ++b)
#pragma unroll
                for (int m = 0; m < 4; ++m)
#pragma unroll
                    for (int n = 0; n < 2; ++n) acc[a][b][m][n] = (f32x4){0.f, 0.f, 0.f, 0.f};
        cur = nxt; cA = nA; cB = nB; ++ui;
        if constexpr (ALIGN_EPI) { if (wr == 1) PG8_BAR; }
    }
    PG8_WAIT_V(0);
    if constexpr (!ALIGN_EPI) { if (wr == 0) PG8_BAR; }
    PG8_BAR;
#undef PG8_SA
#undef PG8_SB
#undef PG8_STAGE
#undef PG8_LDA
#undef PG8_LDB
#undef PG8_MMA
#undef PG8_WAIT_V
#undef PG8_WAIT_L
#undef PG8_BAR
#undef PG8_SCHED
}
}

namespace att {
typedef short bf16x8 __attribute__((ext_vector_type(8)));
typedef short s16x4 __attribute__((ext_vector_type(4)));
typedef float f32x16 __attribute__((ext_vector_type(16)));
constexpr int D = 128, NW = 8, QBLK = 32, KVBLK = 64;
constexpr float SCALE = 0.088388347648318440f;
constexpr float THR = 8.f;
constexpr int LDQK = 128, LDO = DM;
constexpr int SHM_V = KVBLK * D * 2, SHM_K = KVBLK * D * 2;
constexpr int OFF_WS = 2 * SHM_V + 2 * SHM_K;
constexpr int OFF_RPB = OFF_WS + NW * 64 * 4 + 1024;
constexpr int OFF_Q = OFF_RPB + 2048 + 1024;
constexpr int ATT_LDS = OFF_Q + 65536;
#define KSWZ(row, colB) ((row) * 256 + ((colB) ^ (((row) & 7) << 4)))
#define SBAR() __builtin_amdgcn_sched_barrier(0)
__device__ __forceinline__ int crow(int r, int hi) { return (r & 3) + 8 * (r >> 2) + 4 * hi; }
__device__ __forceinline__ unsigned cvtpk(float lo, float hi) { unsigned r; asm volatile("v_cvt_pk_bf16_f32 %0, %1, %2" : "=v"(r) : "v"(lo), "v"(hi)); return r; }

__device__ __forceinline__ void partialSM(f32x16& p0, f32x16& p1, float& m_reg, float& mn, float& alpha) {
  constexpr float C = SCALE * 1.4426950408889634f;
  float pmax = p0[0]; for (int r = 1; r < 16; ++r) pmax = fmaxf(pmax, p0[r]); for (int r = 0; r < 16; ++r) pmax = fmaxf(pmax, p1[r]);
  { auto rr = __builtin_amdgcn_permlane32_swap(__float_as_uint(pmax), __float_as_uint(pmax), false, false);
    pmax = fmaxf(__uint_as_float(rr[0]), __uint_as_float(rr[1])); }
  if (__builtin_expect(__all(pmax - m_reg <= THR / SCALE), 1)) { mn = m_reg; alpha = 1.f; }
  else { mn = fmaxf(m_reg, pmax); alpha = __builtin_amdgcn_exp2f((m_reg - mn) * C); m_reg = mn; }
  float mnC = -mn * C;
  for (int r = 0; r < 16; ++r) p0[r] = fmaf(p0[r], C, mnC); for (int r = 0; r < 16; ++r) p1[r] = fmaf(p1[r], C, mnC);
  for (int r = 0; r < 16; ++r) p0[r] = __builtin_amdgcn_exp2f(p0[r]);
}
__device__ __forceinline__ void finishSM(f32x16& p0, f32x16& p1, float alpha, float& l_reg, bf16x8& pa0, bf16x8& pa1, bf16x8& pa2, bf16x8& pa3) {
  for (int r = 0; r < 16; ++r) p1[r] = __builtin_amdgcn_exp2f(p1[r]);
  float ps = 0; for (int r = 0; r < 16; ++r) ps += p0[r]; for (int r = 0; r < 16; ++r) ps += p1[r];
  { auto rr = __builtin_amdgcn_permlane32_swap(__float_as_uint(ps), __float_as_uint(ps), false, false);
    ps = __uint_as_float(rr[0]) + __uint_as_float(rr[1]); }
  l_reg = l_reg * alpha + ps;
#define PK4(P, BASE, OUT) do { unsigned a0 = cvtpk(P[BASE + 0], P[BASE + 1]), a1 = cvtpk(P[BASE + 2], P[BASE + 3]);   \
    unsigned b0 = cvtpk(P[BASE + 4], P[BASE + 5]), b1 = cvtpk(P[BASE + 6], P[BASE + 7]);                              \
    auto r0 = __builtin_amdgcn_permlane32_swap(a0, b0, false, false); auto r1 = __builtin_amdgcn_permlane32_swap(a1, b1, false, false); \
    u32x4 w = {r0[0], r1[0], r0[1], r1[1]}; OUT = *reinterpret_cast<bf16x8*>(&w); } while (0)
  PK4(p0, 0, pa0); PK4(p0, 8, pa1); PK4(p1, 0, pa2); PK4(p1, 8, pa3);
#undef PK4
}
template <int QR>
__device__ __forceinline__ void qkt(f32x16& p0, f32x16& p1, const char* Ks, const bf16x8* qr, const char* qsl, int r32, int hi) {
  p0 = f32x16{}; p1 = f32x16{};
#pragma unroll
  for (int d0 = 0; d0 < 8; ++d0) { int cb = (d0 * 16 + hi * 8) * 2;
    bf16x8 b0 = *reinterpret_cast<const bf16x8*>(Ks + KSWZ(r32, cb));
    bf16x8 b1 = *reinterpret_cast<const bf16x8*>(Ks + KSWZ(32 + r32, cb));
    const bf16x8 q = (d0 < QR) ? qr[d0 < QR ? d0 : 0] : *reinterpret_cast<const bf16x8*>(qsl + d0 * 1024);
    p0 = __builtin_amdgcn_mfma_f32_32x32x16_bf16(b0, q, p0, 0, 0, 0);
    p1 = __builtin_amdgcn_mfma_f32_32x32x16_bf16(b1, q, p1, 0, 0, 0); }
}
__device__ __forceinline__ int v_st(int k, int c) { const int kk = (k & ~0xC) | ((k & 4) << 1) | ((k & 8) >> 1); return ((kk >> 3) * 4 + (c >> 5)) * 512 + ((kk & 7) * 32 + (c & 31)) * 2; }
__device__ __forceinline__ int v_rd_base(int lane) { return ((lane & 3) << 3) | (((lane >> 2) & 3) << 6) | (((lane >> 4) & 1) << 5) | (((lane >> 5) & 1) << 8); }
constexpr int v_rd_off(int d0, int ks, int half) { return d0 * 512 + ks * 4096 + half * 2048; }
template <int OFF> __device__ __forceinline__ s16x4 tr_read(int vb) {
  s16x4 r; asm volatile("ds_read_b64_tr_b16 %0, %1 offset:%2" : "=&v"(r) : "v"(vb), "i"(OFF) : "memory"); return r;
}
template <int D0> __device__ __forceinline__ void pv_one(f32x16& od, int vb, bf16x8 pa0, bf16x8 pa1, bf16x8 pa2, bf16x8 pa3) {
  const s16x4 l0 = tr_read<v_rd_off(D0, 0, 0)>(vb), h0 = tr_read<v_rd_off(D0, 0, 1)>(vb), l1 = tr_read<v_rd_off(D0, 1, 0)>(vb), h1 = tr_read<v_rd_off(D0, 1, 1)>(vb);
  const s16x4 l2 = tr_read<v_rd_off(D0, 2, 0)>(vb), h2 = tr_read<v_rd_off(D0, 2, 1)>(vb), l3 = tr_read<v_rd_off(D0, 3, 0)>(vb), h3 = tr_read<v_rd_off(D0, 3, 1)>(vb);
  asm volatile("s_waitcnt lgkmcnt(0)" ::: "memory"); SBAR();
#define PK(L, H) (bf16x8){L[0], L[1], L[2], L[3], H[0], H[1], H[2], H[3]}
  od = __builtin_amdgcn_mfma_f32_32x32x16_bf16(pa0, PK(l0, h0), od, 0, 0, 0);
  od = __builtin_amdgcn_mfma_f32_32x32x16_bf16(pa1, PK(l1, h1), od, 0, 0, 0);
  od = __builtin_amdgcn_mfma_f32_32x32x16_bf16(pa2, PK(l2, h2), od, 0, 0, 0);
  od = __builtin_amdgcn_mfma_f32_32x32x16_bf16(pa3, PK(l3, h3), od, 0, 0, 0);
#undef PK
}
__device__ __forceinline__ void pv_d0(f32x16* o, int vb, bf16x8 pa0, bf16x8 pa1, bf16x8 pa2, bf16x8 pa3) {
  pv_one<0>(o[0], vb, pa0, pa1, pa2, pa3); pv_one<1>(o[1], vb, pa0, pa1, pa2, pa3); pv_one<2>(o[2], vb, pa0, pa1, pa2, pa3); pv_one<3>(o[3], vb, pa0, pa1, pa2, pa3);
}

template <int MASK>
__device__ __forceinline__ void apply_mask(f32x16& p0, f32x16& p1, int jt, int NTR, int lat_t0, int q0lat, int wid, int r32, int hi, const float* rpbs) {
  if constexpr (MASK == 0) return;
  if (jt < 4) return;
  constexpr float NEG = -1e30f;
  if (jt >= NTR) {
#pragma unroll
    for (int r = 0; r < 16; ++r) { p0[r] = NEG; p1[r] = NEG; }
    return; }
  const int tl = lat_t0 + jt - 4;
  if constexpr (MASK == 1) {
    const int qw = q0lat + wid * 32, kp0 = tl * 64;
    if (kp0 + 63 - qw <= 128 && kp0 - (qw + 31) >= -128) return;
    int base = kp0 + 4 * hi - (qw + r32); asm volatile("" : "+v"(base));
#pragma unroll
    for (int r = 0; r < 16; ++r) { const int dk = base + (r & 3) + 8 * (r >> 2), dk1 = dk + 32;
      p0[r] = (dk > 128 || dk < -128) ? NEG : p0[r]; p1[r] = (dk1 > 128 || dk1 < -128) ? NEG : p1[r]; }
  } else {
    const int qr = (q0lat >> 6) + (wid >> 1), qc = (wid & 1) * 32 + r32;
    const int rs = min(max(qr - 4, 0), 120);
    if (tl < rs || tl >= rs + 8) {
#pragma unroll
      for (int r = 0; r < 16; ++r) { p0[r] = NEG; p1[r] = NEG; }
      return; }
    const int cs = min(max(qc - 8, 0), 48);
    int boff = ((tl - qr + 7) * 31 + (15 - qc) + 4 * hi) * 4; int d = 4 * hi - cs; asm volatile("" : "+v"(boff), "+v"(d));
    const volatile LAS float* brow = (const volatile LAS float*)((const LAS char*)rpbs + boff);
#pragma unroll
    for (int g = 0; g < 4; ++g) {
      float b0[4], b1[4];
#pragma unroll
      for (int j = 0; j < 4; ++j) { b0[j] = brow[8 * g + j]; b1[j] = brow[8 * g + j + 32]; }
#pragma unroll
      for (int j = 0; j < 4; ++j) { const int r = 4 * g + j, t0 = d + 8 * g + j, t1 = t0 + 32;
        p0[r] = ((unsigned)t0 < 16u) ? p0[r] + b0[j] : NEG; p1[r] = ((unsigned)t1 < 16u) ? p1[r] + b1[j] : NEG; }
      SBAR();
    }
  }
}

template <int MASK, int QR>
__device__ __forceinline__ void attn_unit(const bf16* __restrict__ Qb, const bf16* __restrict__ Kb, const bf16* __restrict__ Vb, bf16* __restrict__ Ob,
                                          int NT, int NTR, int lat_t0, int q0lat, float sink_l2, char* lds, const int tid) {
  const int wid = __builtin_amdgcn_readfirstlane(tid >> 6), lane = tid & 63, r32 = lane & 31, hi = lane >> 5;
  char* V_lds = lds; char* K_lds = lds + 2 * SHM_V;
  float* ws = (float*)(lds + OFF_WS) + wid * 64; float* li_l = ws; float* al_l = ws + 32;
  const float* rpbs = (const float*)(lds + OFF_RPB);
  float m_reg = -1e30f, l_reg = 0; f32x16 o[4] = {}; bf16x8 qr[QR > 0 ? QR : 1];
  char* qsl = lds + OFF_Q + wid * 8192 + lane * 16;
  { const unsigned qoff = (unsigned)(((wid * QBLK + r32) * LDQK + hi * 8) * 2);
#pragma unroll
    for (int d0 = 0; d0 < 8; ++d0) { const bf16x8 q = *reinterpret_cast<const bf16x8*>((const char*)Qb + qoff + d0 * 32);
      if (d0 < QR) qr[d0 < QR ? d0 : 0] = q; else *reinterpret_cast<bf16x8*>(qsl + d0 * 1024) = q; } }
  const int sr = tid >> 4, sc = (tid & 15) * 8, vst0 = v_st(sr, sc), vst1 = v_st(32 + sr, sc);
  const int vb0 = (int)(uintptr_t)V_lds + v_rd_base(lane);
  const unsigned ldoff0 = (unsigned)((sr * LDQK + sc) * 2), ldoff1 = ldoff0 + (unsigned)(32 * LDQK * 2);
  struct { bf16x8 vs0, vs1, ks0, ks1; } sr_[2];
#define KROW(jt) ((jt) >= NTR ? 0 : ((jt) < 4 ? 64 * (jt) : 256 + 64 * (lat_t0 + (jt) - 4)))
#define SLOAD(i, jt) do { const size_t kb_ = (size_t)(KROW(jt)) * (LDQK * 2); const char* vt_ = (const char*)Vb + kb_; const char* kt_ = (const char*)Kb + kb_; \
    sr_[i].vs0 = *reinterpret_cast<const bf16x8*>(vt_ + ldoff0); sr_[i].vs1 = *reinterpret_cast<const bf16x8*>(vt_ + ldoff1); \
    sr_[i].ks0 = *reinterpret_cast<const bf16x8*>(kt_ + ldoff0); sr_[i].ks1 = *reinterpret_cast<const bf16x8*>(kt_ + ldoff1); } while (0)
#define SWRITE(b, i) do { *(bf16x8*)(V_lds + (b) * SHM_V + vst0) = sr_[i].vs0;          \
    *(bf16x8*)(V_lds + (b) * SHM_V + vst1) = sr_[i].vs1; int kc = sc * 2;               \
    *(bf16x8*)(K_lds + (b) * SHM_K + KSWZ(sr, kc)) = sr_[i].ks0;                       \
    *(bf16x8*)(K_lds + (b) * SHM_K + KSWZ(32 + sr, kc)) = sr_[i].ks1; } while (0)
#define SWAIT() asm volatile("s_waitcnt vmcnt(4)" ::: "memory")
#define RESC(a) do { if (__any((a) < 1.f)) { if (hi == 0) al_l[r32] = (a); asm volatile("s_waitcnt lgkmcnt(0)" ::: "memory"); \
    for (int d = 0; d < 4; ++d) for (int r = 0; r < 16; ++r) o[d][r] *= al_l[crow(r, hi)]; } } while (0)
  f32x16 pA0, pA1, pB0, pB1; float mnA, mnB, alA, alB; bf16x8 pa0, pa1, pa2, pa3;
  constexpr int SE = 0, SO = 1;
  const int qw_ = q0lat + wid * 32, qr_ = (q0lat >> 6) + (wid >> 1), rs_ = min(max(qr_ - 4, 0), 120);
#define NEED(jt) (MASK == 0 || (jt) < 4 || ((jt) < NTR && (MASK == 1 ? ((lat_t0 + (jt) - 4) * 64 + 63 >= qw_ - 128 && (lat_t0 + (jt) - 4) * 64 <= qw_ + 31 + 128) \
                                                                   : (lat_t0 + (jt) - 4 >= rs_ && lat_t0 + (jt) - 4 < rs_ + 8))))
  bool nA = true, nB = true;
  SLOAD(SE, 0); asm volatile("s_waitcnt vmcnt(0)" ::: "memory"); SWRITE(0, SE); __syncthreads();
  qkt<QR>(pA0, pA1, K_lds, qr, qsl, r32, hi); partialSM(pA0, pA1, m_reg, mnA, alA);
  SLOAD(SO, 1); if (2 < NT) SLOAD(SE, 2);
  SWAIT(); SWRITE(1, SO); __syncthreads();
  for (int j = 1; j + 1 < NT; j += 2) {
    nB = NEED(j);
    SBAR(); if (nB) { qkt<QR>(pB0, pB1, K_lds + SHM_K, qr, qsl, r32, hi); apply_mask<MASK>(pB0, pB1, j, NTR, lat_t0, q0lat, wid, r32, hi, rpbs); }
    if (nA) finishSM(pA0, pA1, alA, l_reg, pa0, pa1, pa2, pa3); SBAR();
    SLOAD(SO, j + 2); SBAR();
    if (nA) pv_d0(o, vb0, pa0, pa1, pa2, pa3);
    if (nB) partialSM(pB0, pB1, m_reg, mnB, alB); else alB = 1.f;
    __syncthreads(); SWAIT(); SWRITE(0, SE);
    RESC(alB); __syncthreads();
    nA = NEED(j + 1);
    SBAR(); if (nA) { qkt<QR>(pA0, pA1, K_lds, qr, qsl, r32, hi); apply_mask<MASK>(pA0, pA1, j + 1, NTR, lat_t0, q0lat, wid, r32, hi, rpbs); }
    if (nB) finishSM(pB0, pB1, alB, l_reg, pa0, pa1, pa2, pa3); SBAR();
    if (j + 3 < NT) SLOAD(SE, j + 3); SBAR();
    if (nB) pv_d0(o, vb0 + (int)SHM_V, pa0, pa1, pa2, pa3);
    if (nA) partialSM(pA0, pA1, m_reg, mnA, alA); else alA = 1.f;
    __syncthreads(); SWAIT(); SWRITE(1, SO);
    RESC(alA); __syncthreads();
  }
  nB = NEED(NT - 1);
  SBAR(); if (nB) { qkt<QR>(pB0, pB1, K_lds + SHM_K, qr, qsl, r32, hi); apply_mask<MASK>(pB0, pB1, NT - 1, NTR, lat_t0, q0lat, wid, r32, hi, rpbs); }
  if (nA) finishSM(pA0, pA1, alA, l_reg, pa0, pa1, pa2, pa3); SBAR();
  if (nA) pv_d0(o, vb0, pa0, pa1, pa2, pa3);
  if (nB) partialSM(pB0, pB1, m_reg, mnB, alB); else alB = 1.f;
  __syncthreads(); RESC(alB);
  if (nB) { finishSM(pB0, pB1, alB, l_reg, pa0, pa1, pa2, pa3); SBAR();
    pv_d0(o, vb0 + (int)SHM_V, pa0, pa1, pa2, pa3); }
#undef NEED
  { constexpr float C = SCALE * 1.4426950408889634f; l_reg += __builtin_amdgcn_exp2f(sink_l2 - m_reg * C); }
  if (hi == 0) li_l[r32] = l_reg; asm volatile("s_waitcnt lgkmcnt(0)" ::: "memory");
  float rli[16];
#pragma unroll
  for (int r = 0; r < 16; ++r) rli[r] = 1.0f / li_l[crow(r, hi)];
  { int r32e = r32, hie = hi; asm volatile("" : "+v"(r32e), "+v"(hie));
    const unsigned ooff = (unsigned)(((wid * QBLK + 4 * hie) * LDO + r32e) * 2);
#pragma unroll
    for (int r = 0; r < 16; ++r) { const unsigned ro = ooff + (unsigned)((((r & 3) + 8 * (r >> 2)) * LDO) * 2);
#pragma unroll
      for (int d0 = 0; d0 < 4; ++d0) *(bf16*)((char*)Ob + ro + d0 * 64) = (bf16)f2bf(o[d0][r] * rli[r]); } }
  __syncthreads();
#undef KROW
#undef SLOAD
#undef SWRITE
#undef SWAIT
#undef RESC
}
}

#define XB_TMO      128
#define XB_XCNT(j)  (256  + 64 * (j))
#define XB_XSUB(j)  (1280 + 64 * (j))
#define XB_XGEN(j)  (2304 + 64 * (j))
#define XB_TOP      3328
#define XB_TOPGEN   3392
#define XCD_BAR_WORDS 3456
#define XB_SPIN_CAP (1u << 18)

__device__ __forceinline__ unsigned xb_ld(unsigned* p)              { return __hip_atomic_load(p, __ATOMIC_RELAXED, __HIP_MEMORY_SCOPE_AGENT); }
__device__ __forceinline__ unsigned xb_add(unsigned* p, unsigned v) { return __hip_atomic_fetch_add(p, v, __ATOMIC_RELAXED, __HIP_MEMORY_SCOPE_AGENT); }
__device__ __forceinline__ unsigned xb_xcc_id() { return (unsigned)__builtin_amdgcn_s_getreg((3 << 11) | 20) & 0xFu; }
#define XB_SPIN(cond, bar) do { unsigned _sp = 0; while (cond) { __builtin_amdgcn_s_sleep(1); \
    if ((++_sp & 255u) == 0u) { if (xb_ld(&(bar)[XB_TMO])) break; if (_sp > XB_SPIN_CAP) { atomicAdd(&(bar)[XB_TMO], 1u); break; } } } } while (0)

struct XcdBarrier { unsigned* bar; unsigned x; volatile LAS unsigned* st; };

__device__ __forceinline__ XcdBarrier xcd_barrier_post(unsigned* bar, volatile LAS unsigned* st) {
    XcdBarrier b; b.bar = bar; b.x = xb_xcc_id(); b.st = st;
    if (threadIdx.x == 0) (void)xb_add(&bar[XB_XCNT(b.x)], 1u);
    return b;
}
__device__ __forceinline__ void xcd_barrier_complete(unsigned* bar, unsigned x, unsigned& nloc, unsigned& nx) {
    const unsigned G = gridDim.x * gridDim.y * gridDim.z;
    unsigned sum, cnt, mine, sp = 0u;
    for (;;) {
        sum = 0u; cnt = 0u; mine = 0u;
#pragma unroll
        for (unsigned j = 0; j < 16; ++j) { const unsigned c = xb_ld(&bar[XB_XCNT(j)]); sum += c; cnt += (c > 0u) ? 1u : 0u; mine = (j == x) ? c : mine; }
        if (sum == G) break;
        __builtin_amdgcn_s_sleep(1);
        if ((++sp & 255u) == 0u) { if (xb_ld(&bar[XB_TMO])) break; if (sp > XB_SPIN_CAP) { atomicAdd(&bar[XB_TMO], 1u); break; } }
    }
    nloc = mine > 0u ? mine : 1u; nx = cnt > 0u ? cnt : 1u;
}
__device__ __forceinline__ void xcd_barrier(const XcdBarrier& b) {
    asm volatile("s_waitcnt vmcnt(0)" ::: "memory");
    __syncthreads();
    if (threadIdx.x == 0) {
        unsigned* bar = b.bar;
        __builtin_amdgcn_s_waitcnt(0);
        unsigned nloc = b.st[0], nx = b.st[1];
        if (nloc == 0u) { xcd_barrier_complete(bar, b.x, nloc, nx); b.st[0] = nloc; b.st[1] = nx; }
        const unsigned old = xb_add(&bar[XB_XSUB(b.x)], 1u);
        const unsigned gen = old / nloc;
        if (old + 1u == (gen + 1u) * nloc) {
            __builtin_amdgcn_fence(__ATOMIC_RELEASE, "agent");
            asm volatile("s_waitcnt vmcnt(0)" ::: "memory");
            const unsigned og = xb_add(&bar[XB_TOP], 1u);
            const unsigned tg = og / nx;
            if (og + 1u == (tg + 1u) * nx) xb_add(&bar[XB_TOPGEN], 1u);
            else XB_SPIN(xb_ld(&bar[XB_TOPGEN]) == tg, bar);
            __builtin_amdgcn_fence(__ATOMIC_ACQUIRE, "agent");
            xb_add(&bar[XB_XGEN(b.x)], 1u);
            asm volatile("s_waitcnt vmcnt(0)" ::: "memory");
        } else {
            XB_SPIN(xb_ld(&bar[XB_XGEN(b.x)]) == gen, bar);
            __builtin_amdgcn_fence(__ATOMIC_ACQUIRE, "agent");
            asm volatile("s_waitcnt vmcnt(0)" ::: "memory");
        }
    }
    __syncthreads();
}

constexpr size_t MiB = 1u << 20;
constexpr size_t WS_CTL = 0, CTL_ZERO_BYTES = 1 * MiB;
constexpr size_t WS_MOD = 1 * MiB;
constexpr size_t WS_MODP = 2 * MiB;
constexpr size_t WS_ROPE = 7 * MiB;
constexpr size_t WS_GV = 7 * MiB + 512 * 1024;
constexpr size_t WS_CS = 8 * MiB;
constexpr size_t WS_W = 12 * MiB;
constexpr size_t W_IN_B = (size_t)DIN * DM * 2, W_OUT_B = (size_t)DM * DM * 2, W_UP_B = (size_t)DFF * DM * 2, W_DOWN_B = (size_t)DM * DFF * 2;
constexpr size_t W_LAYER_B = W_IN_B + W_OUT_B + W_UP_B + W_DOWN_B;
constexpr size_t WS_H = WS_W + DEPTH * W_LAYER_B;
constexpr size_t WS_QKV = WS_H + 66 * MiB;
constexpr size_t WS_Y = WS_QKV + 149 * MiB;
constexpr size_t WS_HID = WS_Y + 66 * MiB;
constexpr size_t WS_SLAB = WS_HID + 264 * MiB;
constexpr size_t WS_END = WS_SLAB + 64 * MiB;
static_assert((size_t)MT * DM * 2 <= 66 * MiB && (size_t)MT * DIN * 2 <= 149 * MiB && (size_t)MT * DFF * 2 <= 264 * MiB, "ws map");
constexpr int CW_BAR = 4096;

constexpr int RING_BYTES = 131072;
constexpr int LDS_BYTES = 163840;
constexpr int MISC_OFF = LDS_BYTES - 1024;
static_assert(att::ATT_LDS <= MISC_OFF && RING_BYTES <= MISC_OFF, "LDS map");

__device__ const float ROPE_INV[32] = {
    1.000000000e+00f, 7.498942614e-01f, 5.623413324e-01f, 4.216965139e-01f, 3.162277639e-01f, 2.371373773e-01f, 1.778279394e-01f, 1.333521307e-01f,
    1.000000015e-01f, 7.498941571e-02f, 5.623413250e-02f, 4.216965288e-02f, 3.162277490e-02f, 2.371373773e-02f, 1.778279431e-02f, 1.333521493e-02f,
    9.999999776e-03f, 7.498941850e-03f, 5.623413250e-03f, 4.216964822e-03f, 3.162277630e-03f, 2.371373586e-03f, 1.778279431e-03f, 1.333521446e-03f,
    1.000000047e-03f, 7.498942432e-04f, 5.623413017e-04f, 4.216965172e-04f, 3.162277571e-04f, 2.371373703e-04f, 1.778279402e-04f, 1.333521504e-04f };

__device__ __forceinline__ void sincos_d(double x, double& s, double& c) {
    const double kd = __builtin_rint(x * 0.63661977236758134308); const int k = (int)kd;
    double r = __builtin_fma(-kd, 1.57079632679489655800e+00, x); r = __builtin_fma(-kd, 6.12323399573676603587e-17, r);
    const double z = r * r;
    double sp = -1.0 / 355687428096000.0;
    sp = sp * z + 1.0 / 1307674368000.0; sp = sp * z - 1.0 / 6227020800.0; sp = sp * z + 1.0 / 39916800.0; sp = sp * z - 1.0 / 362880.0; sp = sp * z + 1.0 / 5040.0; sp = sp * z - 1.0 / 120.0; sp = sp * z + 1.0 / 6.0;
    const double sn = r - r * z * sp;
    double cp = 1.0 / 20922789888000.0;
    cp = cp * z - 1.0 / 87178291200.0; cp = cp * z + 1.0 / 479001600.0; cp = cp * z - 1.0 / 3628800.0; cp = cp * z + 1.0 / 40320.0; cp = cp * z - 1.0 / 720.0; cp = cp * z + 1.0 / 24.0; cp = cp * z - 0.5;
    const double cs = 1.0 + z * cp;
    switch (k & 3) { case 0: s = sn; c = cs; break; case 1: s = cs; c = -sn; break; case 2: s = -sn; c = -cs; break; default: s = -cs; c = sn; break; }
}

#ifndef QR_A
#define QR_A 8
#endif
#ifndef QR_M
#define QR_M 0
#endif
struct Args { const float* in[16]; float* out; unsigned char* ws; int ph_lo, ph_hi; };
constexpr int N_PHASES = 2 + 8 * DEPTH;

template <bool QKPERM>
__device__ __forceinline__ void p0_transpose_item(const float* W, int K, int N, bf16* WT, LAS float* scr, int item, int lane) {
    const int nblk = N / 32, kb = item / nblk, nb = item % nblk, k0 = 64 * kb, n0 = 32 * nb;
#pragma unroll 8
    for (int i = 0; i < 32; ++i) { const int kk = 2 * i + (lane >> 5); scr[kk * 33 + (lane & 31)] = __builtin_nontemporal_load(W + (size_t)(k0 + kk) * N + n0 + (lane & 31)); }
    asm volatile("s_waitcnt lgkmcnt(0)" ::: "memory");
    const int c = lane & 7;
#pragma unroll
    for (int j = 0; j < 4; ++j) { const int n = (lane >> 3) + 8 * j; const LAS float* s = scr + (8 * c) * 33 + n;
        u32x4 o; o.x = pk2(s[0 * 33], s[1 * 33]); o.y = pk2(s[2 * 33], s[3 * 33]); o.z = pk2(s[4 * 33], s[5 * 33]); o.w = pk2(s[6 * 33], s[7 * 33]);
        int nr = n0 + n;
        if (QKPERM) { const int slot = nr >> 7, e = nr & 127; const bool isv = (slot == 6 || slot == 7 || (slot >= 20 && slot < 26) || slot >= 34);
            if (!isv) nr = (slot << 7) | (e & 64) | (((e >> 2) & 7) << 3) | (((e >> 5) & 1) << 2) | (e & 3); }
        *(u32x4*)(WT + (size_t)nr * K + k0 + 8 * c) = o; }
    asm volatile("s_waitcnt lgkmcnt(0)" ::: "memory");
}

template <class T> __device__ __forceinline__ T* as_global(T* p) { GAS T* g = (GAS T*)p; asm volatile("" : "+s"(g)); return (T*)g; }
#define PHASE_BEGIN() \
    int tid; asm volatile("v_mbcnt_lo_u32_b32 %0, -1, 0\n\tv_mbcnt_hi_u32_b32 %0, -1, %0" : "=v"(tid)); tid += wave0 * 64; \
    const CAS Args* ap = (const CAS Args*)__builtin_amdgcn_kernarg_segment_ptr(); asm volatile("" : "+s"(ap)); \
    int G = gridDim.x, bx = blockIdx.x; asm volatile("" : "+s"(G), "+s"(bx)); \
    const int lane = tid & 63, wave = __builtin_amdgcn_readfirstlane(tid >> 6); \
    const int vcu = (G % 8 == 0) ? (bx % 8) * (G / 8) + bx / 8 : bx; const int gw = vcu * 8 + wave, NGW = G * 8; \
    unsigned char* const ws = as_global(ap->ws); \
    (void)lane; (void)gw; (void)NGW; (void)ws
#define P_IN(k) (as_global(ap->in[k]))
#define P_XS (as_global(ap->out))
#define P_CS ((float*)(ws + WS_CS))
#define P_MOD ((float*)(ws + WS_MOD))
#define P_MODP ((float*)(ws + WS_MODP))
#define P_ROPE ((float2*)(ws + WS_ROPE))
#define P_GV ((float*)(ws + WS_GV))
#define P_HB ((bf16*)(ws + WS_H))
#define P_QKV ((bf16*)(ws + WS_QKV))
#define P_YB ((bf16*)(ws + WS_Y))
#define P_HID ((bf16*)(ws + WS_HID))
#define P_SLAB ((float*)(ws + WS_SLAB))

__global__ void __launch_bounds__(512, 2) trunk_fwd(Args args) {
    extern __shared__ __attribute__((aligned(16))) unsigned char lds[];
    LAS unsigned char* ldsl = (LAS unsigned char*)lds;
    volatile LAS unsigned* MISC = (volatile LAS unsigned*)(ldsl + MISC_OFF);
    for (int u = threadIdx.x; u < (LDS_BYTES - MISC_OFF) / 4; u += 512) ((LAS unsigned*)(ldsl + MISC_OFF))[u] = 0u;
    const int wave0 = __builtin_amdgcn_readfirstlane((int)threadIdx.x >> 6);
    __syncthreads();
    const int lo = args.ph_lo, hi = args.ph_hi;
    unsigned* const barw = (unsigned*)(args.ws + WS_CTL) + CW_BAR;
    XcdBarrier bar; bar.bar = barw; bar.x = 0; bar.st = nullptr;
    if (hi - lo > 1) bar = xcd_barrier_post(barw, MISC + 8);
#define IN(k) (lo <= (k) && (k) < hi)
#define SEAM(k) do { if ((k) + 1 < hi) xcd_barrier(bar); } while (0)

    if (IN(0)) {
        PHASE_BEGIN();
        const float* c_in = P_IN(1); const float* cctx_in = P_IN(3); const float* w_mod = P_IN(4);
        LAS float* cond = (LAS float*)(ldsl + 8 * 8448);
        for (int i = tid; i < 3 * DM; i += 512) { const float v = (i < 2 * DM) ? c_in[i] : cctx_in[i - 2 * DM]; cond[i] = v / (1.0f + expf(-v)); }
        __syncthreads();
        float* modp = P_MODP;
        for (int it = gw; it < DEPTH * 48 * 8; it += NGW) {
            const int l = it / 384, r = it % 384, nb = r >> 3, kc = r & 7, k0 = kc * 256, n0 = nb * 256 + 4 * lane;
            const float* W = w_mod + ((size_t)l * DM + k0) * MODW + n0;
            f32x4 a0 = {0.f, 0.f, 0.f, 0.f}, a1 = a0, a2 = a0;
#pragma unroll 8
            for (int kk = 0; kk < 256; ++kk) { const f32x4 w = __builtin_nontemporal_load((const f32x4*)(W + (size_t)kk * MODW));
                a0 += cond[k0 + kk] * w; a1 += cond[DM + k0 + kk] * w; a2 += cond[2 * DM + k0 + kk] * w; }
            float* P = modp + ((size_t)(l * 8 + kc) * 3) * MODW + n0;
            *(f32x4*)(P) = a0; *(f32x4*)(P + MODW) = a1; *(f32x4*)(P + 2 * MODW) = a2;
        }
        if (bx == 0) { float2* ropet = P_ROPE; for (int i = tid; i < 128 * 32; i += 512) { const int pos = i >> 5, f = i & 31; const float ang = (float)pos * ROPE_INV[f]; double sn, cn; sincos_d((double)ang, sn, cn); ropet[i] = make_float2((float)cn, (float)sn); } }
        LAS float* scr = (LAS float*)(ldsl + wave * 8448);
        constexpr int I_IN = (DM / 64) * (DIN / 32), I_OUT = (DM / 64) * (DM / 32), I_UP = (DM / 64) * (DFF / 32), I_DOWN = (DFF / 64) * (DM / 32);
        constexpr int I_LAYER = I_IN + I_OUT + I_UP + I_DOWN;
        for (int it = gw; it < DEPTH * I_LAYER; it += NGW) {
            const int l = it / I_LAYER; int r = it % I_LAYER;
            unsigned char* wl = ws + WS_W + (size_t)l * W_LAYER_B;
            if (r < I_IN) { p0_transpose_item<true>(P_IN(8) + (size_t)l * DM * DIN, DM, DIN, (bf16*)wl, scr, r, lane); continue; } r -= I_IN;
            if (r < I_OUT) { p0_transpose_item<false>(P_IN(13) + (size_t)l * DM * DM, DM, DM, (bf16*)(wl + W_IN_B), scr, r, lane); continue; } r -= I_OUT;
            if (r < I_UP) { p0_transpose_item<false>(P_IN(14) + (size_t)l * DM * DFF, DM, DFF, (bf16*)(wl + W_IN_B + W_OUT_B), scr, r, lane); continue; } r -= I_UP;
            p0_transpose_item<false>(P_IN(15) + (size_t)l * DFF * DM, DFF, DM, (bf16*)(wl + W_IN_B + W_OUT_B + W_UP_B), scr, r, lane);
        }
        SEAM(0);
    }
    if (IN(1)) {
        PHASE_BEGIN();
        const float* b_mod = P_IN(5); const float* modp = P_MODP; float* modv = P_MOD; const float* nrm_a = P_IN(6); const float* nrm_m = P_IN(7); float* gvw = P_GV;
        for (int i = (vcu * 512 + tid) * 4; i < DEPTH * 3 * MODW; i += G * 512 * 4) {
            const int l = i / (3 * MODW), r = i % (3 * MODW), v = r / MODW, n = r % MODW;
            f32x4 s = *(const f32x4*)(b_mod + (size_t)l * MODW + n);
#pragma unroll
            for (int kc = 0; kc < 8; ++kc) s += *(const f32x4*)(modp + ((size_t)(l * 8 + kc) * 3 + v) * MODW + n);
            *(f32x4*)(modv + i) = s;
            const int part = n / DM;
            if (part == 1 || part == 4) { const int wh = part == 4, c = n - part * DM; const f32x4 g = *(const f32x4*)((wh ? nrm_m : nrm_a) + (size_t)l * DM + c);
                *(f32x4*)(gvw + (((size_t)l * 2 + wh) * 3 + v) * DM + c) = g * (1.0f + s); }
        }
        SEAM(1);
    }

#define NORM_FINISH(m, xv, ss, V) do { const float rstd = 1.0f / sqrtf((ss) * (1.0f / DM) + EPS); \
        const float* gvp = gvl + (size_t)(V) * DM; const float* shp = modl + (size_t)(V) * MODW + (which_) * 3 * DM; bf16* orow = Hb + (size_t)(m) * DM; \
        _Pragma("unroll") for (int j = 0; j < 8; ++j) { const int cidx = 4 * lane + 256 * j; const f32x4 gq = *(const f32x4*)(gvp + cidx), shq = *(const f32x4*)(shp + cidx); \
            const f32x4 h = (xv[j] * rstd) * gq + shq; u32x2 w; w.x = pk2(h[0], h[1]); w.y = pk2(h[2], h[3]); *(u32x2*)(orow + cidx) = w; } } while (0)
#define NORM_CTX_ROWS(NSLAB, CRES, GATE) do { \
        LAS float* red = (LAS float*)ldsl; float* csw = P_CS; const float* slab = P_SLAB; \
        const float* gvp = gvl + (size_t)2 * DM; const float* shp = modl + (size_t)2 * MODW + which_ * 3 * DM; \
        f32x4 xr[2]; float ssr[2]; const int cc = 256 * wave + 4 * lane; \
        _Pragma("unroll") for (int rr = 0; rr < 2; ++rr) { const int r = 2 * vcu + rr; ssr[rr] = 0.f; xr[rr] = (f32x4){0.f, 0.f, 0.f, 0.f}; \
            if (r < 2 * CTX) { f32x4 x = *(const f32x4*)((CRES) + (size_t)r * DM + cc); \
                if ((NSLAB) > 0) { f32x4 a = {0.f, 0.f, 0.f, 0.f}; for (int sp = 0; sp < (NSLAB); ++sp) a += *(const f32x4*)(slab + ((size_t)sp * 512 + r) * DM + cc); \
                    x += *(const f32x4*)((GATE) + cc) * a; *(f32x4*)(csw + (size_t)r * DM + cc) = x; } \
                xr[rr] = x; ssr[rr] = (x[0] * x[0] + x[1] * x[1]) + (x[2] * x[2] + x[3] * x[3]); } } \
        wave_sum2(ssr[0], ssr[1]); \
        if (lane == 0) { red[wave] = ssr[0]; red[8 + wave] = ssr[1]; } \
        __syncthreads(); \
        _Pragma("unroll") for (int rr = 0; rr < 2; ++rr) { const int r = 2 * vcu + rr; \
            if (r < 2 * CTX) { float tot = 0.f; _Pragma("unroll") for (int w8 = 0; w8 < 8; ++w8) tot += red[rr * 8 + w8]; \
                const float rstd = 1.0f / sqrtf(tot * (1.0f / DM) + EPS); const f32x4 gq = *(const f32x4*)(gvp + cc), shq = *(const f32x4*)(shp + cc); \
                const f32x4 h = (xr[rr] * rstd) * gq + shq; u32x2 w; w.x = pk2(h[0], h[1]); w.y = pk2(h[2], h[3]); \
                *(u32x2*)(Hb + ((size_t)(r >> 8) * TPB + (r & 255)) * DM + cc) = w; } } \
        __syncthreads(); } while (0)
#define NORM_SETUP(which) const int which_ = (which); const float* __restrict__ modl = P_MOD + (size_t)l * 3 * MODW; const float* __restrict__ gvl = P_GV + ((size_t)l * 2 + which_) * 3 * DM; bf16* __restrict__ Hb = P_HB
#define NORM_PHASE(FIRST) do { \
        const float* __restrict__ src_lat = (FIRST) ? P_IN(0) : (const float*)P_XS; \
        for (int r0 = gw; r0 < NB * SEQ; r0 += 4 * NGW) { \
            int rq[4]; bool hq[4]; f32x4 xq[4][8]; float sq[4]; \
            _Pragma("unroll") for (int q = 0; q < 4; ++q) { const int rr_ = r0 + q * NGW; hq[q] = rr_ < NB * SEQ; rq[q] = hq[q] ? rr_ : r0; } \
            _Pragma("unroll") for (int q = 0; q < 4; ++q) { const float* sp_ = src_lat + (size_t)rq[q] * DM + 4 * lane; \
                _Pragma("unroll") for (int j = 0; j < 8; ++j) xq[q][j] = __builtin_nontemporal_load((const f32x4*)(sp_ + 256 * j)); } \
            _Pragma("unroll") for (int q = 0; q < 4; ++q) { float a_ = 0.f; \
                _Pragma("unroll") for (int j = 0; j < 8; ++j) a_ += (xq[q][j][0] * xq[q][j][0] + xq[q][j][1] * xq[q][j][1]) + (xq[q][j][2] * xq[q][j][2] + xq[q][j][3] * xq[q][j][3]); sq[q] = a_; } \
            wave_sum2(sq[0], sq[1]); wave_sum2(sq[2], sq[3]); \
            _Pragma("unroll") for (int q = 0; q < 4; ++q) if (hq[q]) { const int v_ = rq[q] >> 13; NORM_FINISH(v_ * TPB + CTX + (rq[q] & (SEQ - 1)), xq[q], sq[q], v_); } \
        } } while (0)

    for (int l = 0; l < DEPTH; ++l) {
        const int pb = 2 + 8 * l; const bool lastl = (l == DEPTH - 1);

        if (IN(pb + 0)) { PHASE_BEGIN(); NORM_SETUP(0); NORM_PHASE(l == 0);
            if (l == 0) NORM_CTX_ROWS(0, P_IN(2), P_IN(2)); else NORM_CTX_ROWS(16, (const float*)P_CS, P_MOD + ((size_t)(l - 1) * 3 + 2) * MODW + 5 * DM);
            SEAM(pb + 0); }

        if (IN(pb + 1)) {
            PHASE_BEGIN();
            pg8::Gemm g{P_HB, (const bf16*)(ws + WS_W + (size_t)l * W_LAYER_B), MT, DIN, DM, DM}; pg8::TileOrder S; S.init(66, DIN / 256, G, bx, 0, DM);
            pg8::EpiQKV E{P_QKV, P_IN(9) + (size_t)l * 384, P_IN(10) + (size_t)l * 384, (const float*)P_ROPE, (LAS float*)(ldsl + RING_BYTES)};
            pg8::gemm_phase<pg8::EpiQKV, pg8::TileOrder, true, true>(ldsl, g, S, E, tid);
            SEAM(pb + 1);
        }


        if (IN(pb + 3)) {
            PHASE_BEGIN();
            char* alds = (char*)lds; const bf16* QKV = P_QKV; bf16* Yb = P_YB; const float* sinks = P_IN(12);
#define QH(col, row) (QKV + ((size_t)((col) >> 7) * MT + (row)) * 128)
            for (int k = 0; k < 2; ++k) {
                int q_row0 = 0, qcol = 0, kcol = 0, vcol = 0, ycol = 0, bb = 0, NT = 4; float sink = -1e30f; bool run = false;
                if (k == 0) { if (vcu < 256) { const int i = vcu; run = true; bb = i >> 7; const int hq = (i >> 5) & 3, qb = i & 31; q_row0 = bb * TPB + CTX + qb * 256; qcol = hq * 128; kcol = 512 + (hq >> 1) * 128; vcol = 768 + (hq >> 1) * 128; ycol = hq * 128; NT = 132; } }
                else if (!lastl) { const int i = (vcu + G - G / 2) % G; if (i < 32) { run = true; bb = i >> 4; const int h16 = i & 15; q_row0 = bb * TPB; ycol = h16 * 128; NT = 4;
                        if (h16 < 4) { qcol = h16 * 128; kcol = 512 + (h16 >> 1) * 128; vcol = 768 + (h16 >> 1) * 128; }
                        else if (h16 < 10) { const int h = h16 - 4; qcol = 1024 + h * 128; kcol = 1792 + h * 128; vcol = 2560 + h * 128; }
                        else { const int h = h16 - 10; qcol = 3328 + h * 128; kcol = 4096 + (h / 3) * 128; vcol = 4352 + (h / 3) * 128; sink = sinks[l * 6 + h] * 1.4426950408889634f; } } }
                if (run) att::attn_unit<0, QR_A>(QH(qcol, q_row0), QH(kcol, bb * TPB), QH(vcol, bb * TPB), Yb + (size_t)q_row0 * DM + ycol, NT, NT, 0, 0, sink, alds, tid);
            }
            for (int i = vcu; i < 384; i += G) {
                const int bb = i / 192, rem = i % 192, h = rem >> 5, qb = rem & 31, r0 = qb * 4;
                const int rlo = min(max(r0 - 4, 0), 120), rhi = min(max(r0 + 3 - 4, 0), 120) + 7, NTR = 4 + (rhi - rlo + 1), NT = (NTR + 1) & ~1;
                const int q_row0 = bb * TPB + CTX + qb * 256;
                { float* rp = (float*)(alds + att::OFF_RPB); const float* src = P_IN(11) + ((size_t)l * 6 + h) * 465; for (int e = tid; e < 465; e += 512) rp[e] = src[e] * (1.0f / att::SCALE); }
                att::attn_unit<2, QR_M>(QH(1024 + h * 128, q_row0), QH(1792 + h * 128, bb * TPB), QH(2560 + h * 128, bb * TPB), Yb + (size_t)q_row0 * DM + 512 + h * 128, NT, NTR, rlo, qb * 256, -1e30f, alds, tid);
            }
            for (int i = G - 1 - vcu; i < 384; i += G) {
                const int bb = i / 192, rem = i % 192, h = rem >> 5, qb = rem & 31, q0 = qb * 256;
                const int tlo = max(q0 - 128, 0) >> 6, thi = min(q0 + 384, SEQ) >> 6, NTR = 4 + (thi - tlo), NT = (NTR + 1) & ~1;
                const int q_row0 = bb * TPB + CTX + q0;
                att::attn_unit<1, QR_M>(QH(3328 + h * 128, q_row0), QH(4096 + (h / 3) * 128, bb * TPB), QH(4352 + (h / 3) * 128, bb * TPB), Yb + (size_t)q_row0 * DM + 1280 + h * 128, NT, NTR, tlo, q0, sinks[l * 6 + h] * 1.4426950408889634f, alds, tid);
            }
            SEAM(pb + 3);
        }

        if (IN(pb + 4)) {
            PHASE_BEGIN();
            pg8::Gemm g{P_YB, (const bf16*)(ws + WS_W + (size_t)l * W_LAYER_B + W_IN_B), MT, DM, DM, DM}; pg8::TileOrder S; S.init(64, DM / 256, G, bx, 1, DM); if (!lastl) S.add_ctx_split(8);
            pg8::EpiRes E{(l == 0) ? P_IN(0) : (const float*)P_XS, (l == 0) ? P_IN(2) : (const float*)P_CS, P_XS, P_CS, P_MOD + (size_t)l * 3 * MODW + 2 * DM, P_SLAB};
            pg8::gemm_phase<pg8::EpiRes, pg8::TileOrder, true, true>(ldsl, g, S, E, tid);
            SEAM(pb + 4);
        }
        if (IN(pb + 5)) { PHASE_BEGIN(); NORM_SETUP(1); NORM_PHASE(false);
            if (!lastl) { if (l == 0) NORM_CTX_ROWS(8, P_IN(2), P_MOD + ((size_t)l * 3 + 2) * MODW + 2 * DM); else NORM_CTX_ROWS(8, (const float*)P_CS, P_MOD + ((size_t)l * 3 + 2) * MODW + 2 * DM); }
            SEAM(pb + 5); }

        if (IN(pb + 6)) {
            PHASE_BEGIN();
            pg8::Gemm g{P_HB, (const bf16*)(ws + WS_W + (size_t)l * W_LAYER_B + W_IN_B + W_OUT_B), MT, DFF, DM, DM}; pg8::TileOrder S; S.init(lastl ? 64 : 66, DFF / 256, G, bx, lastl ? 1 : 0, DM);
            pg8::EpiBf16<3> E{P_HID, DFF};
            pg8::gemm_phase<pg8::EpiBf16<3>, pg8::TileOrder, true, true>(ldsl, g, S, E, tid);
            SEAM(pb + 6);
        }
        if (IN(pb + 7)) {
            PHASE_BEGIN();
            pg8::Gemm g{P_HID, (const bf16*)(ws + WS_W + (size_t)l * W_LAYER_B + W_IN_B + W_OUT_B + W_UP_B), MT, DM, DFF, DFF}; pg8::TileOrder S; S.init(64, DM / 256, G, bx, 1, DFF); if (!lastl) S.add_ctx_split(16);
            pg8::EpiRes E{P_XS, P_CS, P_XS, P_CS, P_MOD + (size_t)l * 3 * MODW + 5 * DM, P_SLAB};
            pg8::gemm_phase<pg8::EpiRes, pg8::TileOrder, true, true>(ldsl, g, S, E, tid);
            SEAM(pb + 7);
        }
    }
#undef IN
#undef SEAM
}

extern "C" void kernel_launch(void* const* d_in, const int* in_sizes, int n_in, void* d_out, int out_size, void* d_ws, size_t ws_size, hipStream_t stream) {
    static int grid = 0;
    if (grid == 0) {
        if (n_in != 16 || in_sizes[0] != NB * SEQ * DM || out_size != NB * SEQ * DM || ws_size < WS_END) {
            fprintf(stderr, "kernel_launch: shape mismatch: n_in %d in0 %d out %d ws %zu (need %zu)\n", n_in, n_in > 0 ? in_sizes[0] : -1, out_size, ws_size, (size_t)WS_END); grid = -1; return; }
        int dev = 0, cus = 0, per_cu = 0;
        if (hipGetDevice(&dev) != hipSuccess || hipDeviceGetAttribute(&cus, hipDeviceAttributeMultiprocessorCount, dev) != hipSuccess) { fprintf(stderr, "kernel_launch: device query failed\n"); grid = -1; return; }
        if (hipFuncSetAttribute((const void*)trunk_fwd, hipFuncAttributeMaxDynamicSharedMemorySize, LDS_BYTES) != hipSuccess) { fprintf(stderr, "kernel_launch: hipFuncSetAttribute failed\n"); grid = -1; return; }
        if (hipOccupancyMaxActiveBlocksPerMultiprocessor(&per_cu, (const void*)trunk_fwd, 512, LDS_BYTES) != hipSuccess || per_cu < 1)
            fprintf(stderr, "kernel_launch: note: occupancy query reports %d workgroups per CU\n", per_cu);
        (void)hipGetLastError();
        grid = cus;
    }
    if (grid < 0) return;
    if (hipMemsetAsync((char*)d_ws + WS_CTL, 0, CTL_ZERO_BYTES, stream) != hipSuccess) { fprintf(stderr, "kernel_launch: memset failed\n"); return; }
    Args a{};
    for (int i = 0; i < 16; ++i) a.in[i] = (const float*)d_in[i];
    a.out = (float*)d_out; a.ws = (unsigned char*)d_ws;
#if MK_PER_PHASE_LAUNCH
    for (int p = 0; p < N_PHASES; ++p) {
        a.ph_lo = p; a.ph_hi = p + 1;
        hipLaunchKernelGGL(trunk_fwd, dim3(grid), dim3(512), LDS_BYTES, stream, a);
    }
#else
    a.ph_lo = 0; a.ph_hi = N_PHASES;
    hipLaunchKernelGGL(trunk_fwd, dim3(grid), dim3(512), LDS_BYTES, stream, a);
#endif
    const hipError_t le = hipPeekAtLastError();
    if (le != hipSuccess) fprintf(stderr, "kernel_launch: launch failed: %s\n", hipGetErrorName(le));
}
```
